# Optimizing an MI355X kernel written in HIP

```python
import jax, jax.numpy as jnp
from jax import lax
import numpy as np

D_MODEL = 1024
BATCH = 1
SEQ = 16384
DEPTH = 1
DEC_BATCH = 8
DEC_SEQ = 64
PAST_LEN = 1024

CHUNK = 64
MIX_WIDTH = D_MODEL
ATTN_WIDTH = MIX_WIDTH // 2
POOL_WIDTH = MIX_WIDTH - ATTN_WIDTH
HEAD_DIM = 64
N_HEADS = ATTN_WIDTH // HEAD_DIM
POOL_WINDOWS = (2, 4, 8, 16)
N_POOL_GROUPS = len(POOL_WINDOWS)
POOL_GROUP = POOL_WIDTH // N_POOL_GROUPS
POOL_HIST = max(POOL_WINDOWS) - 1
Q_BLOCK = 128
EPS = 1e-6
IN_COLS = 4 * ATTN_WIDTH + N_HEADS + 2 * POOL_WIDTH

kernel_name = "fox_pool_hybrid_stream_step"


def rmsnorm(x, g):
    xf = x.astype(jnp.float32)
    y = xf * lax.rsqrt(jnp.mean(xf * xf, axis=-1, keepdims=True) + EPS)
    return (y * g.astype(jnp.float32)).astype(x.dtype)


def ada_terms(c, w_ada, b_ada):
    m = jax.nn.silu(c) @ w_ada + b_ada
    shift, scale, gate = jnp.split(m, 3, axis=-1)
    return shift, scale, gate


def project(x, c, norm_g, w_ada, b_ada, w_in, b_f):
    shift, scale, gate = ada_terms(c, w_ada, b_ada)
    h = rmsnorm(x, norm_g) * (1.0 + scale[:, None, :]) + shift[:, None, :]
    p = h @ w_in
    B, L, _ = p.shape
    A = ATTN_WIDTH
    q = p[..., 0:A].reshape(B, L, N_HEADS, HEAD_DIM)
    k = p[..., A:2 * A].reshape(B, L, N_HEADS, HEAD_DIM)
    v = p[..., 2 * A:3 * A].reshape(B, L, N_HEADS, HEAD_DIM)
    ag = p[..., 3 * A:4 * A]
    o = 4 * A
    logf = jax.nn.log_sigmoid(p[..., o:o + N_HEADS].astype(jnp.float32) + b_f.astype(jnp.float32))
    o += N_HEADS
    u = p[..., o:o + POOL_WIDTH]
    pg = p[..., o + POOL_WIDTH:o + 2 * POOL_WIDTH]
    return q, k, v, ag, logf, u, pg, gate


def fox_prompt(q, k, v, logf):
    B, L, H, dh = q.shape
    nb = L // Q_BLOCK
    Ft = jnp.cumsum(logf, axis=1).transpose(0, 2, 1)
    qb = q.reshape(B, nb, Q_BLOCK, H, dh).transpose(1, 0, 2, 3, 4)
    Fb = Ft.reshape(B, H, nb, Q_BLOCK).transpose(2, 0, 1, 3)
    kpos = jnp.arange(L)
    sc = 1.0 / np.sqrt(dh).astype(np.float32)

    def blk(args):
        qi, Fi, i = args
        qpos = i * Q_BLOCK + jnp.arange(Q_BLOCK)
        s = jnp.einsum('bqhd,bkhd->bhqk', qi, k, preferred_element_type=jnp.float32) * sc
        s = s + (Fi[:, :, :, None] - Ft[:, :, None, :])
        s = jnp.where(kpos[None, :] <= qpos[:, None], s, -jnp.inf)
        pr = jax.nn.softmax(s, axis=-1)
        return jnp.einsum('bhqk,bkhd->bqhd', pr.astype(v.dtype), v)

    out = lax.map(blk, (qb, Fb, jnp.arange(nb)))
    return out.transpose(1, 0, 2, 3, 4).reshape(B, L, H * dh)


def fox_sample(q, k_new, v_new, logf_new, cache_k, cache_v, cache_logf):
    B, L, H, dh = q.shape
    P = cache_k.shape[1]
    k = jnp.concatenate([cache_k.astype(k_new.dtype), k_new], axis=1)
    v = jnp.concatenate([cache_v.astype(v_new.dtype), v_new], axis=1)
    lf = jnp.concatenate([cache_logf.astype(jnp.float32), logf_new], axis=1)
    Ft = jnp.cumsum(lf, axis=1).transpose(0, 2, 1)
    sc = 1.0 / np.sqrt(dh).astype(np.float32)
    s = jnp.einsum('bqhd,bkhd->bhqk', q, k, preferred_element_type=jnp.float32) * sc
    s = s + (Ft[:, :, P:, None] - Ft[:, :, None, :])
    qpos = P + jnp.arange(L)
    kpos = jnp.arange(P + L)
    s = jnp.where(kpos[None, :] <= qpos[:, None], s, -jnp.inf)
    pr = jax.nn.softmax(s, axis=-1)
    return jnp.einsum('bhqk,bkhd->bqhd', pr.astype(v.dtype), v).reshape(B, L, H * dh)


def pool_mix(u_ext, start_pos, w_pool, pool_scale):
    B, E, C = u_ext.shape
    L = E - POOL_HIST
    uf = u_ext.astype(jnp.float32)
    cs = jnp.concatenate([jnp.zeros((B, 1, C), jnp.float32), jnp.cumsum(uf, axis=1)], axis=1)
    hi = cs[:, POOL_HIST + 1:POOL_HIST + 1 + L]
    pos = start_pos + jnp.arange(L)
    means = []
    for g, w in enumerate(POOL_WINDOWS):
        sl = slice(g * POOL_GROUP, (g + 1) * POOL_GROUP)
        lo = cs[:, POOL_HIST + 1 - w:POOL_HIST + 1 - w + L, sl]
        cnt = jnp.minimum(pos + 1, w).astype(jnp.float32)[None, :, None]
        means.append((hi[..., sl] - lo) / cnt)
    d = (jnp.concatenate(means, axis=-1) - uf[:, POOL_HIST:]).astype(u_ext.dtype)
    d = d.reshape(B, L, N_POOL_GROUPS, POOL_GROUP)
    y = jnp.einsum('blgc,gcd->blgd', d, w_pool).reshape(B, L, C)
    return y * pool_scale


def merge(x, attn, ag, pool, pg, gate, w_out):
    z = jnp.concatenate([attn * jax.nn.silu(ag), pool * jax.nn.silu(pg)], axis=-1)
    return x + gate[:, None, :] * (z @ w_out)


def setup_inputs(seed: int = 0) -> dict:
    key = jax.random.key(seed)
    ks = jax.random.split(key, 20)
    f32 = jnp.float32
    D = D_MODEL
    nrm = lambda k, s: jax.random.normal(k, s, f32)
    return {
        "x_prompt": nrm(ks[0], (BATCH, SEQ, D)),
        "x_sample": nrm(ks[1], (DEC_BATCH, DEC_SEQ, D)),
        "c_prompt": nrm(ks[2], (BATCH, D)),
        "c_sample": nrm(ks[3], (DEC_BATCH, D)),
        "cache_k": nrm(ks[4], (DEPTH, DEC_BATCH, PAST_LEN, N_HEADS, HEAD_DIM)),
        "cache_v": nrm(ks[5], (DEPTH, DEC_BATCH, PAST_LEN, N_HEADS, HEAD_DIM)),
        "cache_logf": jax.nn.log_sigmoid(nrm(ks[6], (DEPTH, DEC_BATCH, PAST_LEN, N_HEADS)) + 2.0),
        "state_pool": nrm(ks[7], (DEPTH, DEC_BATCH, POOL_HIST, POOL_WIDTH)),
        "norm_g": 1.0 + 0.05 * nrm(ks[8], (DEPTH, D)),
        "w_ada": 0.3 * D ** -0.5 * nrm(ks[9], (DEPTH, D, 3 * D)),
        "b_ada": 0.02 * nrm(ks[10], (DEPTH, 3 * D)),
        "w_in": D ** -0.5 * nrm(ks[11], (DEPTH, D, IN_COLS)),
        "b_f": 0.1 * nrm(ks[12], (DEPTH, N_HEADS)),
        "w_pool": POOL_GROUP ** -0.5 * nrm(ks[13], (DEPTH, N_POOL_GROUPS, POOL_GROUP, POOL_GROUP)),
        "pool_scale": 1.0 + 0.1 * nrm(ks[14], (DEPTH, POOL_WIDTH)),
        "w_out": MIX_WIDTH ** -0.5 * nrm(ks[15], (DEPTH, MIX_WIDTH, D)),
        "final_g": 1.0 + 0.05 * nrm(ks[16], (D,)),
    }


def reference(x_prompt, x_sample, c_prompt, c_sample, cache_k, cache_v, cache_logf, state_pool,
              norm_g, w_ada, b_ada, w_in, b_f, w_pool, pool_scale, w_out, final_g):
    xp, xs = x_prompt, x_sample
    past = cache_k.shape[2]
    kp_l, vp_l, fp_l, pp_l, ks_l, vs_l, fs_l, ps_l = [], [], [], [], [], [], [], []
    for l in range(DEPTH):
        q, k, v, ag, logf, u, pg, gate = project(xp, c_prompt, norm_g[l], w_ada[l], b_ada[l], w_in[l], b_f[l])
        attn = fox_prompt(q, k, v, logf)
        u_ext = jnp.pad(u, ((0, 0), (POOL_HIST, 0), (0, 0)))
        pool = pool_mix(u_ext, 0, w_pool[l], pool_scale[l])
        xp = merge(xp, attn, ag, pool, pg, gate, w_out[l])
        kp_l.append(k); vp_l.append(v); fp_l.append(logf); pp_l.append(u_ext[:, -POOL_HIST:])

        q, k, v, ag, logf, u, pg, gate = project(xs, c_sample, norm_g[l], w_ada[l], b_ada[l], w_in[l], b_f[l])
        attn = fox_sample(q, k, v, logf, cache_k[l], cache_v[l], cache_logf[l])
        u_ext = jnp.concatenate([state_pool[l].astype(u.dtype), u], axis=1)
        pool = pool_mix(u_ext, past, w_pool[l], pool_scale[l])
        xs = merge(xs, attn, ag, pool, pg, gate, w_out[l])
        ks_l.append(k); vs_l.append(v); fs_l.append(logf); ps_l.append(u_ext[:, -POOL_HIST:])

    y_prompt = rmsnorm(xp, final_g)
    y_sample = rmsnorm(xs, final_g)
    k_prompt = jnp.stack(kp_l); v_prompt = jnp.stack(vp_l)
    logf_prompt = jnp.stack(fp_l); pool_prompt = jnp.stack(pp_l)
    k_sample = jnp.stack(ks_l); v_sample = jnp.stack(vs_l)
    logf_sample = jnp.stack(fs_l); pool_sample = jnp.stack(ps_l)
    return (y_prompt, y_sample, k_prompt, v_prompt, logf_prompt, pool_prompt,
            k_sample, v_sample, logf_sample, pool_sample)
```

```cpp
#include <hip/hip_runtime.h>
#include <hip/hip_cooperative_groups.h>
#include <cstdio>
#include <cstdint>
namespace cg = cooperative_groups;
namespace pg8 {
#define PG8_LAS __attribute__((address_space(3)))
typedef unsigned short bf16_t;
typedef short bf16x8 __attribute__((ext_vector_type(8)));
typedef float f32x4 __attribute__((ext_vector_type(4)));
typedef unsigned u32x4 __attribute__((ext_vector_type(4)));
constexpr int BM = 256, BK = 64, HALF = 128, HTB = HALF * BK * 2  , STAGE_BYTES = 8 * HTB, NXCD = 8, WGM = 8;

__host__ __device__ __forceinline__ int lds_byte(int r, int c) { const int st = (r >> 4) * 2 + (c >> 5), rr = r & 15, cc = c & 31, ob = rr * 64 + cc * 2; return st * 1024 + (ob ^ (((ob >> 9) & 1) << 5)); }
__host__ __device__ __forceinline__ void stage_rc(int b, int& R, int& C) { const int st = b / 1024, sb = b % 1024, swz = sb ^ (((sb >> 9) & 1) << 5); R = (st >> 1) * 16 + swz / 64; C = (st & 1) * 32 + (swz % 64) / 2; }
__host__ __device__ __forceinline__ int perm32(int rho) { const int n = rho >> 4, i = rho & 15; return 8 * (i >> 2) + 4 * n + (i & 3); }

struct Unit { int pm, pn; };
struct Gemm { const bf16_t* A; const bf16_t* Bt; int M, N, K; };

struct StaticOrder {
    int nM, nN, nwg, G, c;
    __host__ __device__ void init(int M, int N, int G_, int c_) { nM = M / BM; nN = N / BM; nwg = nM * nN; G = G_; c = c_; }
    __host__ __device__ bool next(int i, Unit& u) const {
        const long L = (long)i * G + c; if (L >= nwg) return false;
        int wgid = (int)L; { const int q = nwg / NXCD, r = nwg % NXCD, xcd = wgid % NXCD, off = wgid / NXCD; wgid = (xcd < r ? xcd * (q + 1) : r * (q + 1) + (xcd - r) * q) + off; }
        const int nig = WGM * nN, gid = wgid / nig, fm = gid * WGM, gsz = (nM - fm) < WGM ? (nM - fm) : WGM;
        u.pm = fm + ((wgid % nig) % gsz); u.pn = (wgid % nig) / gsz; return true;
    }
    __device__ __forceinline__ void a_ready(const Unit&) const {}
    __device__ __forceinline__ void done(const Unit&) const {}
};

__device__ __forceinline__ unsigned cvt_pk_bf16(float lo, float hi) { unsigned r; asm volatile("v_cvt_pk_bf16_f32 %0, %1, %2" : "=v"(r) : "v"(lo), "v"(hi)); return r; }

struct EpiProj {
    static constexpr bool PERM = true, AFTER_DRAIN = false;
    bf16_t* PB; float* out; unsigned* qkmax;
    __device__ __forceinline__ void operator()(const f32x4 (&acc)[2][2][4][2], const Unit& u, int wr, int wc, int fr, int fq) const {
        const int row0 = u.pm * BM + wr * 64 + fr; const int col0 = u.pn * BM + wc * 32 + 8 * fq;
#pragma unroll
        for (int ai = 0; ai < 2; ++ai)
#pragma unroll
            for (int m = 0; m < 4; ++m) { bf16_t* rowp = PB + (size_t)(row0 + ai * HALF + m * 16) * 3072 + col0;
#pragma unroll
                for (int bj = 0; bj < 2; ++bj) { const f32x4 v0 = acc[ai][bj][m][0], v1 = acc[ai][bj][m][1];
                    u32x4 w; w.x = cvt_pk_bf16(v0[0], v0[1]); w.y = cvt_pk_bf16(v0[2], v0[3]); w.z = cvt_pk_bf16(v1[0], v1[1]); w.w = cvt_pk_bf16(v1[2], v1[3]);
                    *(u32x4*)(rowp + bj * HALF) = w; } }
        if (u.pn >= 2 && u.pn < 6) {
            const size_t obase = (u.pn < 4) ? (u.pm < 64 ? (size_t)17301504 : (size_t)34217472) : (u.pm < 64 ? (size_t)25690112 : (size_t)34479616);
            float* base = out + obase;
            const int rowl = (u.pm < 64 ? u.pm : u.pm - 64) * BM + wr * 64 + fr; const int colf = (u.pn & 1) * BM + wc * 32 + 8 * fq;
#pragma unroll
            for (int ai = 0; ai < 2; ++ai)
#pragma unroll
                for (int m = 0; m < 4; ++m) { float* rp = base + (size_t)(rowl + ai * HALF + m * 16) * 512 + colf;
#pragma unroll
                    for (int bj = 0; bj < 2; ++bj) { *(f32x4*)(rp + bj * HALF) = acc[ai][bj][m][0]; *(f32x4*)(rp + bj * HALF + 4) = acc[ai][bj][m][1]; } }
        }
        if (u.pn < 4) {
#pragma unroll
            for (int bj = 0; bj < 2; ++bj) { float mx = 0.f;
#pragma unroll
                for (int ai = 0; ai < 2; ++ai)
#pragma unroll
                    for (int m = 0; m < 4; ++m) { const f32x4 a = acc[ai][bj][m][0], b = acc[ai][bj][m][1];
                        float s = (a[0] * a[0] + a[1] * a[1]) + (a[2] * a[2] + a[3] * a[3]) + (b[0] * b[0] + b[1] * b[1]) + (b[2] * b[2] + b[3] * b[3]);
                        s += __shfl_xor(s, 16); s += __shfl_xor(s, 32); mx = fmaxf(mx, s); }
                mx = fmaxf(mx, __shfl_xor(mx, 1)); mx = fmaxf(mx, __shfl_xor(mx, 2)); mx = fmaxf(mx, __shfl_xor(mx, 4)); mx = fmaxf(mx, __shfl_xor(mx, 8));
                if (fr == 0 && fq == 0) atomicMax(qkmax + (u.pn * 8 + bj * 4 + wc), __float_as_uint(mx)); }
        }
    }
};
struct EpiMerge {
    static constexpr bool PERM = true, AFTER_DRAIN = false;
    const float* xp; const float* xs; float* yp; float* ys; const float* adaM; const float* b_ada; float* rowss;
    __device__ __forceinline__ void operator()(const f32x4 (&acc)[2][2][4][2], const Unit& u, int wr, int wc, int fr, int fq) const {
        const bool pr = u.pm < 64; const int rowl = (pr ? u.pm : u.pm - 64) * BM + wr * 64 + fr;
        const float* xb = pr ? xp : xs; float* yb = pr ? yp : ys; const int col0 = u.pn * BM + wc * 32 + 8 * fq;
#pragma unroll
        for (int ai = 0; ai < 2; ++ai) {
            const int bi = pr ? 0 : 1 + (u.pm - 64) * 4 + 2 * ai + wr;
            f32x4 gt[2][2];
#pragma unroll
            for (int bj = 0; bj < 2; ++bj)
#pragma unroll
                for (int n = 0; n < 2; ++n) gt[bj][n] = *(const f32x4*)(adaM + bi * 3072 + 2048 + col0 + bj * HALF + 4 * n) + *(const f32x4*)(b_ada + 2048 + col0 + bj * HALF + 4 * n);
#pragma unroll
            for (int m = 0; m < 4; ++m) { const size_t off = (size_t)(rowl + ai * HALF + m * 16) * 1024 + col0; float ss = 0.f;
#pragma unroll
                for (int bj = 0; bj < 2; ++bj)
#pragma unroll
                    for (int n = 0; n < 2; ++n) { const f32x4 xv = *(const f32x4*)(xb + off + bj * HALF + 4 * n); const f32x4 o = xv + gt[bj][n] * acc[ai][bj][m][n];
                        *(f32x4*)(yb + off + bj * HALF + 4 * n) = o; ss += (o[0] * o[0] + o[1] * o[1]) + (o[2] * o[2] + o[3] * o[3]); }
                ss += __shfl_xor(ss, 16); ss += __shfl_xor(ss, 32);
                if (fq == 0) atomicAdd(rowss + u.pm * BM + ai * HALF + wr * 64 + m * 16 + fr, ss); }
        }
    }
};

template <class Epi, class Sched, bool ALIGN_EPI = false, bool SP2 = false>
__device__ __forceinline__ void gemm_phase(PG8_LAS unsigned char* lds, const Gemm g, const Sched& S, const Epi& E) {
    const int tid = threadIdx.x, wid = __builtin_amdgcn_readfirstlane(tid >> 6), lane = tid & 63, wr = wid >> 2, wc = wid & 3, fr = lane & 15, fq = lane >> 4;
    const int K = g.K, nt = K / BK;
    unsigned voffA[2], voffB[2];
#pragma unroll
    for (int i = 0; i < 2; ++i) { int R, C; stage_rc(tid * 16 + i * 8192, R, C); const int Rb = Epi::PERM ? ((R & ~31) + perm32(R & 31)) : R;
        voffA[i] = (unsigned)(R * K + C) * 2u; voffB[i] = (unsigned)(Rb * K + C) * 2u; }
    const size_t kstep = (size_t)(BK * 2);
    const size_t hstep = (size_t)HALF * K * 2;
    const size_t tstep = 2 * hstep;
    const unsigned ldsw = (unsigned)wid * 1024u;
    const int aoff = lds_byte(wr * 64 + fr, fq * 8), boff = lds_byte(wc * 32 + fr, fq * 8);
#define PG8_SA(b, h) (((b) * 2 + (h)) * HTB)
#define PG8_SB(b, h) ((4 + (b) * 2 + (h)) * HTB)
#define PG8_STAGE(bufoff, gbase, voff) do { _Pragma("unroll") for (int _i = 0; _i < 2; ++_i) \
        __builtin_amdgcn_global_load_lds((const unsigned*)((const char*)(gbase) + (voff)[_i]), (PG8_LAS unsigned*)(lds + (bufoff) + ldsw + _i * 8192), 16, 0, 0); } while (0)
#define PG8_LDA(dst, b, h) do { _Pragma("unroll") for (int m = 0; m < 4; ++m) _Pragma("unroll") for (int k = 0; k < 2; ++k) dst[m][k] = *(const PG8_LAS bf16x8*)(lds + PG8_SA(b, h) + aoff + m * 2048 + k * 1024); } while (0)
#define PG8_LDB(dst, b, h) do { _Pragma("unroll") for (int n = 0; n < 2; ++n) _Pragma("unroll") for (int k = 0; k < 2; ++k) dst[n][k] = *(const PG8_LAS bf16x8*)(lds + PG8_SB(b, h) + boff + n * 2048 + k * 1024); } while (0)
#define PG8_MMA(ai, bj, At, Bt) do { __builtin_amdgcn_s_setprio(1); _Pragma("unroll") for (int m = 0; m < 4; ++m) _Pragma("unroll") for (int n = 0; n < 2; ++n) _Pragma("unroll") for (int k = 0; k < 2; ++k) \
        acc[ai][bj][m][n] = __builtin_amdgcn_mfma_f32_16x16x32_bf16(Bt[n][k], At[m][k], acc[ai][bj][m][n], 0, 0, 0); __builtin_amdgcn_s_setprio(0); } while (0)
#define PG8_WAIT_V(n) asm volatile("s_waitcnt vmcnt(" #n ")" ::: "memory")
#define PG8_WAIT_L(n) asm volatile("s_waitcnt lgkmcnt(" #n ")" ::: "memory")
#define PG8_BAR __builtin_amdgcn_s_barrier()
#define PG8_SCHED __builtin_amdgcn_sched_barrier(0)
    Unit cur, nxt; int ui = 0;
    if (!S.next(0, cur)) return;
    f32x4 acc[2][2][4][2];
#pragma unroll
    for (int a = 0; a < 2; ++a)
#pragma unroll
        for (int b = 0; b < 2; ++b)
#pragma unroll
            for (int m = 0; m < 4; ++m)
#pragma unroll
                for (int n = 0; n < 2; ++n) acc[a][b][m][n] = (f32x4){0.f, 0.f, 0.f, 0.f};
    bf16x8 At[4][2], B0[2][2], B1[2][2];
    const char* cA = (const char*)g.A + (size_t)cur.pm * tstep; const char* cB = (const char*)g.Bt + (size_t)cur.pn * tstep;
    S.a_ready(cur);
    if constexpr (SP2) {
        PG8_STAGE(PG8_SB(0, 0), cB, voffB); PG8_STAGE(PG8_SB(0, 1), cB + hstep, voffB); PG8_STAGE(PG8_SA(0, 0), cA, voffA); PG8_STAGE(PG8_SA(0, 1), cA + hstep, voffA);
        if (wr == 1) PG8_BAR;
        PG8_WAIT_V(2); PG8_BAR;
        PG8_STAGE(PG8_SB(1, 0), cB + kstep, voffB); PG8_STAGE(PG8_SA(1, 0), cA + kstep, voffA); PG8_STAGE(PG8_SB(1, 1), cB + hstep + kstep, voffB);
        PG8_WAIT_V(6); PG8_BAR;
    } else {
        PG8_STAGE(PG8_SB(0, 0), cB, voffB); PG8_STAGE(PG8_SA(0, 0), cA, voffA); PG8_STAGE(PG8_SB(0, 1), cB + hstep, voffB); PG8_STAGE(PG8_SA(0, 1), cA + hstep, voffA);
        if (wr == 1) PG8_BAR;
        PG8_WAIT_V(4); PG8_BAR;
        PG8_STAGE(PG8_SB(1, 0), cB + kstep, voffB); PG8_STAGE(PG8_SA(1, 0), cA + kstep, voffA); PG8_STAGE(PG8_SB(1, 1), cB + hstep + kstep, voffB);
        PG8_WAIT_V(6); PG8_BAR;
    }
    for (;;) {
        const bool has_next = S.next(ui + 1, nxt);
        const char* nA = has_next ? (const char*)g.A + (size_t)nxt.pm * tstep : cA; const char* nB = has_next ? (const char*)g.Bt + (size_t)nxt.pn * tstep : cB;
        for (int t = 0; t < nt; t += 2) {
            const bool last = (t == nt - 2);
            const char* a1 = cA + (size_t)(t + 1) * kstep;
            const char* a2 = last ? nA : cA + (size_t)(t + 2) * kstep; const char* b2 = last ? nB : cB + (size_t)(t + 2) * kstep;
            const char* a3 = a2 + kstep; const char* b3 = b2 + kstep;
            if (last && has_next) S.a_ready(nxt);
            if constexpr (SP2) {
            PG8_LDB(B0, 0, 0); PG8_LDB(B1, 0, 1); PG8_SCHED; PG8_LDA(At, 0, 0); PG8_STAGE(PG8_SA(1, 1), a1 + hstep, voffA);
            PG8_WAIT_V(8); PG8_WAIT_L(0); PG8_BAR; PG8_MMA(0, 0, At, B0); PG8_MMA(0, 1, At, B1); PG8_BAR; PG8_SCHED;
            PG8_LDA(At, 0, 1); PG8_STAGE(PG8_SB(0, 0), b2, voffB); PG8_STAGE(PG8_SB(0, 1), b2 + hstep, voffB); PG8_STAGE(PG8_SA(0, 0), a2, voffA);
            PG8_WAIT_V(8); PG8_WAIT_L(0); PG8_BAR; PG8_MMA(1, 0, At, B0); PG8_MMA(1, 1, At, B1); PG8_BAR; PG8_SCHED;
            PG8_LDB(B0, 1, 0); PG8_LDB(B1, 1, 1); PG8_SCHED; PG8_LDA(At, 1, 0); PG8_STAGE(PG8_SA(0, 1), a2 + hstep, voffA);
            PG8_WAIT_V(8); PG8_WAIT_L(0); PG8_BAR; PG8_MMA(0, 0, At, B0); PG8_MMA(0, 1, At, B1); PG8_BAR; PG8_SCHED;
            PG8_LDA(At, 1, 1); PG8_STAGE(PG8_SB(1, 0), b3, voffB); PG8_STAGE(PG8_SB(1, 1), b3 + hstep, voffB); PG8_STAGE(PG8_SA(1, 0), a3, voffA);
            PG8_WAIT_V(8); PG8_WAIT_L(0); PG8_BAR; PG8_MMA(1, 0, At, B0); PG8_MMA(1, 1, At, B1); PG8_BAR; PG8_SCHED;
            } else {
            PG8_LDB(B0, 0, 0); PG8_SCHED; PG8_LDA(At, 0, 0); PG8_STAGE(PG8_SA(1, 1), a1 + hstep, voffA);
            PG8_WAIT_L(8); PG8_BAR; PG8_WAIT_L(0); PG8_MMA(0, 0, At, B0); PG8_BAR; PG8_SCHED;
            PG8_LDB(B1, 0, 1); PG8_STAGE(PG8_SB(0, 0), b2, voffB);
            PG8_BAR; PG8_WAIT_L(0); PG8_MMA(0, 1, At, B1); PG8_BAR;
            PG8_LDA(At, 0, 1); PG8_STAGE(PG8_SA(0, 0), a2, voffA);
            PG8_BAR; PG8_WAIT_L(0); PG8_MMA(1, 0, At, B0); PG8_BAR; PG8_SCHED;
            PG8_STAGE(PG8_SB(0, 1), b2 + hstep, voffB);
            PG8_WAIT_V(6); PG8_BAR; PG8_MMA(1, 1, At, B1); PG8_BAR;
            PG8_LDB(B0, 1, 0); PG8_SCHED; PG8_LDA(At, 1, 0); PG8_STAGE(PG8_SA(0, 1), a2 + hstep, voffA);
            PG8_WAIT_L(8); PG8_BAR; PG8_WAIT_L(0); PG8_MMA(0, 0, At, B0); PG8_BAR; PG8_SCHED;
            PG8_LDB(B1, 1, 1); PG8_STAGE(PG8_SB(1, 0), b3, voffB);
            PG8_BAR; PG8_WAIT_L(0); PG8_MMA(0, 1, At, B1); PG8_BAR;
            PG8_LDA(At, 1, 1); PG8_STAGE(PG8_SA(1, 0), a3, voffA);
            PG8_BAR; PG8_WAIT_L(0); PG8_MMA(1, 0, At, B0); PG8_BAR; PG8_SCHED;
            PG8_STAGE(PG8_SB(1, 1), b3 + hstep, voffB);
            PG8_WAIT_V(6); PG8_BAR; PG8_MMA(1, 1, At, B1); PG8_BAR;
            }
        }
        if constexpr (ALIGN_EPI) { if (wr == 0) PG8_BAR; }
        if constexpr (!Epi::AFTER_DRAIN) { E(acc, cur, wr, wc, fr, fq); S.done(cur); }
        if (!has_next) break;
#pragma unroll
        for (int a = 0; a < 2; ++a)
#pragma unroll
            for (int b = 0; b < 2; ++b)
#pragma unroll
                for (int m = 0; m < 4; ++m)
#pragma unroll
                    for (int n = 0; n < 2; ++n) acc[a][b][m][n] = (f32x4){0.f, 0.f, 0.f, 0.f};
        cur = nxt; cA = nA; cB = nB; ++ui;
        if constexpr (ALIGN_EPI) { if (wr == 1) PG8_BAR; }
    }
    PG8_WAIT_V(0);
    if constexpr (!ALIGN_EPI) { if (wr == 0) PG8_BAR; }
    PG8_BAR;
    if constexpr (Epi::AFTER_DRAIN) { E.fused(acc, cur, wr, wc, fr, fq, lds, wid, lane); S.done(cur); }
#undef PG8_SA
#undef PG8_SB
#undef PG8_STAGE
#undef PG8_LDA
#undef PG8_LDB
#undef PG8_MMA
#undef PG8_WAIT_V
#undef PG8_WAIT_L
#undef PG8_BAR
#undef PG8_SCHED
}
}

typedef unsigned short bf16;
typedef short bf16x8 __attribute__((ext_vector_type(8)));
typedef float f32x4 __attribute__((ext_vector_type(4)));
typedef float f32x16 __attribute__((ext_vector_type(16)));
typedef unsigned u32x4 __attribute__((ext_vector_type(4)));
typedef unsigned u32x2 __attribute__((ext_vector_type(2)));
#define LAS __attribute__((address_space(3)))
constexpr int DM = 1024, SEQ = 16384, NSAMP = 512, MT = SEQ + NSAMP, INC = 3080, NPJ = 3072, PAST = 1024;
constexpr int NCHUNK = MT / 32;
constexpr float EPS = 1e-6f, LOG2E = 1.4426950408889634f;
constexpr float SC2 = 0.125f * LOG2E;
constexpr float THR2 = 40.0f * LOG2E;
constexpr size_t MiB = 1u << 20;
constexpr size_t WS_CTL = 0, CTL_BYTES = 1 * MiB;
constexpr size_t WS_WIN = 2 * MiB, WS_WOUT = 8 * MiB, WS_WP = 10 * MiB, WS_GT = 11 * MiB, WS_TP = 12 * MiB, WS_GC = 12 * MiB + 65536, WS_TC = 12 * MiB + 524288;
constexpr size_t WS_XN = 16 * MiB, WS_PB = 50 * MiB, WS_Z = 150 * MiB, WS_END = 184 * MiB;
constexpr int CW_ADA = 0, CW_ROWSS = 32768, CW_QKMAX = 49920, CW_KCMAX = 49984, CW_CNT = 50048;
constexpr int PB_Q = 0, PB_K = 512, PB_V = 1024, PB_AG = 1536, PB_U = 2048, PB_PG = 2560;
constexpr int LDS_BYTES = 147456;

struct Params {
    const float *x_prompt, *x_sample, *c_prompt, *c_sample, *cache_k, *cache_v, *cache_logf, *state_pool, *norm_g, *w_ada, *b_ada, *w_in, *b_f, *w_pool, *pool_scale, *w_out, *final_g;
    float* out; unsigned char* ws;
};
constexpr size_t O_YP = 0, O_YS = O_YP + (size_t)SEQ * DM, O_KP = O_YS + (size_t)NSAMP * DM, O_VP = O_KP + (size_t)SEQ * 512, O_LFP = O_VP + (size_t)SEQ * 512,
                 O_PP = O_LFP + (size_t)SEQ * 8, O_KS = O_PP + 15 * 512, O_VS = O_KS + (size_t)NSAMP * 512, O_LFS = O_VS + (size_t)NSAMP * 512, O_PS = O_LFS + (size_t)NSAMP * 8, O_END = O_PS + 8 * 15 * 512;

__device__ __forceinline__ unsigned f2bf(float f) { unsigned u = __builtin_bit_cast(unsigned, f); return (u + 0x7fffu + ((u >> 16) & 1u)) >> 16; }
__device__ __forceinline__ unsigned pk2(float lo, float hi) { return f2bf(lo) | (f2bf(hi) << 16); }
__device__ __forceinline__ float bf2f(unsigned short b) { return __uint_as_float(((unsigned)b) << 16); }
__device__ __forceinline__ float wave_sum(float v) {
#pragma unroll
    for (int o = 1; o < 64; o <<= 1) v += __shfl_xor(v, o);
    return v;
}
__device__ __forceinline__ float silu_f(float v) { return v / (1.0f + __expf(-v)); }

__device__ __forceinline__ void tr_item(const float* W, int ldw, int k0, int c0, bf16* WT, int ldt, int n0, float* scr, int lane) {
#pragma unroll 8
    for (int i = 0; i < 32; ++i) { const int kk = 2 * i + (lane >> 5); scr[kk * 33 + (lane & 31)] = W[(size_t)(k0 + kk) * ldw + c0 + (lane & 31)]; }
    asm volatile("s_waitcnt lgkmcnt(0)" ::: "memory");
    const int c = lane & 7;
#pragma unroll
    for (int j = 0; j < 4; ++j) { const int n = (lane >> 3) + 8 * j; const float* s = scr + (8 * c) * 33 + n;
        u32x4 o; o.x = pk2(s[0 * 33], s[1 * 33]); o.y = pk2(s[2 * 33], s[3 * 33]); o.z = pk2(s[4 * 33], s[5 * 33]); o.w = pk2(s[6 * 33], s[7 * 33]);
        *(u32x4*)(WT + (size_t)(n0 + n) * ldt + k0 + 8 * c) = o; }
    asm volatile("s_waitcnt lgkmcnt(0)" ::: "memory");
}

struct AttnState { float m, l; f32x16 o0, o1; };
__device__ __forceinline__ unsigned cvtpk(float lo, float hi) { typedef float f2 __attribute__((ext_vector_type(2))); typedef __bf16 b2 __attribute__((ext_vector_type(2))); f2 v = {lo, hi}; b2 b = __builtin_convertvector(v, b2); return __builtin_bit_cast(unsigned, b); }

template <bool F32SRC, bool DIAG>
__device__ __forceinline__ void attn_tile(AttnState& st, const bf16x8 (&qr)[4], float gqb, const void* kb, const void* vb, const float* g2, int lane) {
    const int r32 = lane & 31, h2 = lane >> 5;
    bf16x8 kf[4]; bf16x8 va[2][2];
    if constexpr (!F32SRC) {
        const bf16* kp = (const bf16*)kb + (size_t)r32 * 3072 + 8 * h2;
#pragma unroll
        for (int d0 = 0; d0 < 4; ++d0) kf[d0] = *(const bf16x8*)(kp + 16 * d0);
        const bf16* vp = (const bf16*)vb + r32;
#pragma unroll
        for (int db = 0; db < 2; ++db)
#pragma unroll
            for (int s = 0; s < 2; ++s) { u32x4 w;
#pragma unroll
                for (int jj = 0; jj < 4; ++jj) { const int r0 = 16 * s + 8 * (jj >> 1) + 4 * h2 + 2 * (jj & 1);
                    const unsigned lo = vp[(size_t)r0 * 3072 + 32 * db], hi = vp[(size_t)(r0 + 1) * 3072 + 32 * db]; w[jj] = lo | (hi << 16); }
                va[db][s] = __builtin_bit_cast(bf16x8, w); }
    } else {
        const float* kp = (const float*)kb + (size_t)r32 * 512 + 8 * h2;
#pragma unroll
        for (int d0 = 0; d0 < 4; ++d0) { const f32x4 a = *(const f32x4*)(kp + 16 * d0), b = *(const f32x4*)(kp + 16 * d0 + 4);
            u32x4 w; w.x = cvtpk(a[0], a[1]); w.y = cvtpk(a[2], a[3]); w.z = cvtpk(b[0], b[1]); w.w = cvtpk(b[2], b[3]); kf[d0] = __builtin_bit_cast(bf16x8, w); }
        const float* vp = (const float*)vb + r32;
#pragma unroll
        for (int db = 0; db < 2; ++db)
#pragma unroll
            for (int s = 0; s < 2; ++s) { u32x4 w;
#pragma unroll
                for (int jj = 0; jj < 4; ++jj) { const int r0 = 16 * s + 8 * (jj >> 1) + 4 * h2 + 2 * (jj & 1);
                    w[jj] = cvtpk(vp[(size_t)r0 * 512 + 32 * db], vp[(size_t)(r0 + 1) * 512 + 32 * db]); }
                va[db][s] = __builtin_bit_cast(bf16x8, w); }
    }
    f32x4 gk[4];
#pragma unroll
    for (int i = 0; i < 4; ++i) gk[i] = *(const f32x4*)(g2 + 8 * i + 4 * h2);
    f32x16 S = {};
#pragma unroll
    for (int d0 = 0; d0 < 4; ++d0) S = __builtin_amdgcn_mfma_f32_32x32x16_bf16(kf[d0], qr[d0], S, 0, 0, 0);
    float mx = -INFINITY;
#pragma unroll
    for (int r = 0; r < 16; ++r) { float v = S[r] * SC2 + (gqb - gk[r >> 2][r & 3]);
        if (DIAG) { const int kvl = (r & 3) + 8 * (r >> 2) + 4 * h2; if (kvl > r32) v = -INFINITY; }
        S[r] = v; mx = fmaxf(mx, v); }
    mx = fmaxf(mx, __shfl_xor(mx, 32));
    const float mn = fmaxf(st.m, mx); const float alpha = __builtin_amdgcn_exp2f(st.m - mn); st.m = mn;
    float sum = 0.f;
#pragma unroll
    for (int r = 0; r < 16; ++r) { S[r] = __builtin_amdgcn_exp2f(S[r] - mn); sum += S[r]; }
    st.l = st.l * alpha + sum;
#pragma unroll
    for (int r = 0; r < 16; ++r) { st.o0[r] *= alpha; st.o1[r] *= alpha; }
    bf16x8 pb[2];
#pragma unroll
    for (int s = 0; s < 2; ++s) { u32x4 w; w.x = cvtpk(S[8 * s + 0], S[8 * s + 1]); w.y = cvtpk(S[8 * s + 2], S[8 * s + 3]); w.z = cvtpk(S[8 * s + 4], S[8 * s + 5]); w.w = cvtpk(S[8 * s + 6], S[8 * s + 7]); pb[s] = __builtin_bit_cast(bf16x8, w); }
    st.o0 = __builtin_amdgcn_mfma_f32_32x32x16_bf16(va[0][0], pb[0], st.o0, 0, 0, 0); st.o0 = __builtin_amdgcn_mfma_f32_32x32x16_bf16(va[0][1], pb[1], st.o0, 0, 0, 0);
    st.o1 = __builtin_amdgcn_mfma_f32_32x32x16_bf16(va[1][0], pb[0], st.o1, 0, 0, 0); st.o1 = __builtin_amdgcn_mfma_f32_32x32x16_bf16(va[1][1], pb[1], st.o1, 0, 0, 0);
}
__device__ __forceinline__ void attn_finish(const AttnState& st, float ltot, const bf16* PB, bf16* Z, int q0, int hd, int lane) {
    const int r32 = lane & 31, h2 = lane >> 5; const float inv = 1.0f / ltot;
    const bf16* agp = PB + (size_t)(q0 + r32) * 3072 + PB_AG + hd * 64 + 4 * h2; bf16* zp = Z + (size_t)(q0 + r32) * 1024 + hd * 64 + 4 * h2;
#pragma unroll
    for (int db = 0; db < 2; ++db)
#pragma unroll
        for (int i = 0; i < 4; ++i) { const u32x2 a = *(const u32x2*)(agp + 32 * db + 8 * i);
            const float a0 = __uint_as_float(a.x << 16), a1 = __uint_as_float(a.x & 0xffff0000u), a2 = __uint_as_float(a.y << 16), a3 = __uint_as_float(a.y & 0xffff0000u);
            const f32x16& o = db ? st.o1 : st.o0;
            u32x2 w; w.x = cvtpk(o[4 * i + 0] * inv * silu_f(a0), o[4 * i + 1] * inv * silu_f(a1)); w.y = cvtpk(o[4 * i + 2] * inv * silu_f(a2), o[4 * i + 3] * inv * silu_f(a3));
            *(u32x2*)(zp + 32 * db + 8 * i) = w; }
}
__device__ __forceinline__ void load_q(bf16x8 (&qr)[4], const bf16* PB, int q0, int hd, int lane) {
    const bf16* qp = PB + (size_t)(q0 + (lane & 31)) * 3072 + PB_Q + hd * 64 + 8 * (lane >> 5);
#pragma unroll
    for (int d0 = 0; d0 < 4; ++d0) qr[d0] = *(const bf16x8*)(qp + 16 * d0);
}

__global__ void __launch_bounds__(512, 2) fox_pool_fwd(Params P) {
    extern __shared__ __attribute__((aligned(16))) unsigned char lds[];
    cg::grid_group grid = cg::this_grid();
    const int tid = threadIdx.x, lane = tid & 63, wave = __builtin_amdgcn_readfirstlane(tid >> 6), G = gridDim.x, bid = blockIdx.x;
    unsigned char* ws = P.ws;
    float* ctlf = (float*)(ws + WS_CTL); unsigned* ctlu = (unsigned*)(ws + WS_CTL);
    float* adaM = ctlf + CW_ADA; float* rowss = ctlf + CW_ROWSS; unsigned* qkmax = ctlu + CW_QKMAX; unsigned* kcmax = ctlu + CW_KCMAX; unsigned* cnt = ctlu + CW_CNT;
    bf16* WIN = (bf16*)(ws + WS_WIN); bf16* WOUT = (bf16*)(ws + WS_WOUT); bf16* WP = (bf16*)(ws + WS_WP);
    float* GT2 = (float*)(ws + WS_GT); float* TP2 = (float*)(ws + WS_TP); float* GC2 = (float*)(ws + WS_GC); float* TC2 = (float*)(ws + WS_TC);
    bf16* XN = (bf16*)(ws + WS_XN); bf16* PB = (bf16*)(ws + WS_PB); bf16* Z = (bf16*)(ws + WS_Z);
    float* ldsf = (float*)lds;

    for (int task = bid; task < 192; task += G) {
        const int cb = task % 12, kc = task / 12, k0 = kc * 64, n0 = cb * 256;
        float* Ssh = ldsf; float* part = ldsf + 1024;
        for (int i = tid; i < 576; i += 512) { const int b = i >> 6, kk = i & 63; const float c = (b == 0) ? P.c_prompt[k0 + kk] : P.c_sample[(b - 1) * 1024 + k0 + kk]; Ssh[i] = silu_f(c); }
        __syncthreads();
        f32x4 acc[9];
#pragma unroll
        for (int b = 0; b < 9; ++b) acc[b] = (f32x4){0.f, 0.f, 0.f, 0.f};
#pragma unroll
        for (int r = 0; r < 8; ++r) { const int k = wave * 8 + r; const f32x4 w = *(const f32x4*)(P.w_ada + (size_t)(k0 + k) * 3072 + n0 + 4 * lane);
#pragma unroll
            for (int b = 0; b < 9; ++b) acc[b] += Ssh[b * 64 + k] * w; }
#pragma unroll
        for (int b = 0; b < 9; ++b) *(f32x4*)(part + (wave * 9 + b) * 256 + 4 * lane) = acc[b];
        __syncthreads();
        for (int i = tid; i < 2304; i += 512) { const int b = i >> 8, n = i & 255; float s = 0.f;
#pragma unroll
            for (int w = 0; w < 8; ++w) s += part[(w * 9 + b) * 256 + n];
            atomicAdd(adaM + b * 3072 + n0 + n, s); }
        __syncthreads();
    }
    {
        float* scr = ldsf + wave * 4096;
        const int gw = bid * 8 + wave, NGW = G * 8;
        for (int it = gw; it < 1536 + 512 + 32; it += NGW) {
            if (it < 1536) { const int kb = it / 96, nb = it % 96, n0 = 32 * nb; tr_item(P.w_in, INC, 64 * kb, n0 < 2048 ? n0 : n0 + 8, WIN, 1024, n0, scr, lane); }
            else if (it < 2048) { const int r = it - 1536, kb = r / 32, nb = r % 32; tr_item(P.w_out, 1024, 64 * kb, 32 * nb, WOUT, 1024, 32 * nb, scr, lane); }
            else { const int r = it - 2048, g = r >> 3, kb = (r >> 2) & 1, nb = r & 3; tr_item(P.w_pool + (size_t)g * 128 * 128, 128, 64 * kb, 32 * nb, WP + (size_t)g * 128 * 128, 128, 32 * nb, scr, lane); }
        }
    }
    grid.sync();

    {
        float* wfs = ldsf;
        float* lfs = ldsf + 8192;
        for (int i = tid; i < 8192; i += 512) wfs[i] = P.w_in[(size_t)(i >> 3) * INC + 2048 + (i & 7)];
        __syncthreads();
        for (int unit = bid; unit < NCHUNK + 256; unit += G) {
            if (unit < NCHUNK) {
                const int m0 = unit * 32;
                for (int r = 0; r < 4; ++r) {
                    const int m = m0 + wave * 4 + r; const bool pr = m < SEQ;
                    const float* xrow = pr ? P.x_prompt + (size_t)m * DM : P.x_sample + (size_t)(m - SEQ) * DM; const int bi = pr ? 0 : 1 + ((m - SEQ) >> 6);
                    f32x4 v[4]; float ss = 0.f;
#pragma unroll
                    for (int j = 0; j < 4; ++j) { v[j] = *(const f32x4*)(xrow + 4 * lane + 256 * j); ss += (v[j][0] * v[j][0] + v[j][1] * v[j][1]) + (v[j][2] * v[j][2] + v[j][3] * v[j][3]); }
                    const float rs = 1.0f / sqrtf(wave_sum(ss) * (1.0f / DM) + EPS);
                    float f[8];
#pragma unroll
                    for (int e = 0; e < 8; ++e) f[e] = 0.f;
#pragma unroll
                    for (int j = 0; j < 4; ++j) { const int col = 4 * lane + 256 * j;
                        const f32x4 g = *(const f32x4*)(P.norm_g + col);
                        const f32x4 sc = *(const f32x4*)(adaM + bi * 3072 + 1024 + col) + *(const f32x4*)(P.b_ada + 1024 + col);
                        const f32x4 sh = *(const f32x4*)(adaM + bi * 3072 + col) + *(const f32x4*)(P.b_ada + col);
                        const f32x4 hv = (v[j] * rs) * g * (1.0f + sc) + sh;
                        u32x2 w; w.x = pk2(hv[0], hv[1]); w.y = pk2(hv[2], hv[3]); *(u32x2*)(XN + (size_t)m * DM + col) = w;
#pragma unroll
                        for (int i = 0; i < 4; ++i) { const f32x4 w0 = *(const f32x4*)(wfs + (col + i) * 8), w1 = *(const f32x4*)(wfs + (col + i) * 8 + 4);
                            f[0] += hv[i] * w0[0]; f[1] += hv[i] * w0[1]; f[2] += hv[i] * w0[2]; f[3] += hv[i] * w0[3]; f[4] += hv[i] * w1[0]; f[5] += hv[i] * w1[1]; f[6] += hv[i] * w1[2]; f[7] += hv[i] * w1[3]; } }
#pragma unroll
                    for (int e = 0; e < 8; ++e) f[e] = wave_sum(f[e]);
                    float fz = f[0];
#pragma unroll
                    for (int e = 1; e < 8; ++e) fz = (lane == e) ? f[e] : fz;
                    if (lane < 8) { const float z = fz + P.b_f[lane]; const float lf = fminf(z, 0.f) - log1pf(__expf(-fabsf(z)));
                        lfs[(wave * 4 + r) * 8 + lane] = lf;
                        if (pr) P.out[O_LFP + (size_t)m * 8 + lane] = lf; else P.out[O_LFS + (size_t)(m - SEQ) * 8 + lane] = lf; }
                }
                __syncthreads();
                if (tid < 8) { float a = 0.f; for (int r = 0; r < 32; ++r) { a += lfs[r * 8 + tid]; GT2[(size_t)tid * MT + m0 + r] = a * LOG2E; } TP2[unit * 8 + tid] = a * LOG2E; }
                __syncthreads();
            } else {
                const int cu = unit - NCHUNK, b = cu >> 5, s0 = (cu & 31) * 32;
                if (tid < 8) { float a = 0.f; for (int r = 0; r < 32; ++r) { a += P.cache_logf[(size_t)(b * PAST + s0 + r) * 8 + tid]; GC2[(size_t)(b * 8 + tid) * PAST + s0 + r] = a * LOG2E; } TC2[cu * 8 + tid] = a * LOG2E; }
                float mx = 0.f;
                for (int r = 0; r < 4; ++r) { const float* kp = P.cache_k + (size_t)(b * PAST + s0 + wave * 4 + r) * 512 + 8 * lane; const f32x4 a = *(const f32x4*)kp, c = *(const f32x4*)(kp + 4);
                    float s = (a[0] * a[0] + a[1] * a[1]) + (a[2] * a[2] + a[3] * a[3]) + (c[0] * c[0] + c[1] * c[1]) + (c[2] * c[2] + c[3] * c[3]);
                    s += __shfl_xor(s, 1); s += __shfl_xor(s, 2); s += __shfl_xor(s, 4); mx = fmaxf(mx, s); }
                if ((lane & 7) == 0) atomicMax(kcmax + (lane >> 3), __float_as_uint(mx));
            }
        }
    }
    grid.sync();

    {
        pg8::Gemm g{XN, WIN, MT, NPJ, DM}; pg8::StaticOrder S; S.init(MT, NPJ, G, bid);
        pg8::EpiProj E{PB, P.out, qkmax};
        static_assert(O_KP == 17301504 && O_KS == 34217472 && O_VP == 25690112 && O_VS == 34479616, "d_out map");
        pg8::gemm_phase<pg8::EpiProj, pg8::StaticOrder, true, true>((LAS unsigned char*)lds, g, S, E);
    }
    grid.sync();

    {
        const int r32 = lane & 31, h2 = lane >> 5;
        if (bid < 64) {
            const int b = bid >> 3, hd = bid & 7, qc = wave & 1, sp = wave >> 1;
            const int q0 = SEQ + b * 64 + 32 * qc;
            const float qm2 = __uint_as_float(qkmax[2 * hd]) + __uint_as_float(qkmax[2 * hd + 1]);
            const float km2 = fmaxf(__uint_as_float(qkmax[16 + 2 * hd]) + __uint_as_float(qkmax[16 + 2 * hd + 1]), __uint_as_float(kcmax[hd]));
            const float qkb2 = 2.0f * 1.02f * SC2 * sqrtf(qm2 * km2);
            bf16x8 qr[4]; load_q(qr, PB, q0, hd, lane);
            const float gq = GT2[(size_t)hd * MT + q0 + r32];
            AttnState st; st.m = -INFINITY; st.l = 0.f; st.o0 = f32x16{}; st.o1 = f32x16{};
            float base = 0.f; int i = 1;
            if (sp == 0) attn_tile<false, true>(st, qr, gq, PB + (size_t)q0 * 3072 + PB_K + hd * 64, PB + (size_t)q0 * 3072 + PB_V + hd * 64, GT2 + (size_t)hd * MT + q0, lane);
            if (qc == 1) { base += TP2[(512 + 2 * b) * 8 + hd];
                if (sp == 1) attn_tile<false, false>(st, qr, gq + base, PB + (size_t)(q0 - 32) * 3072 + PB_K + hd * 64, PB + (size_t)(q0 - 32) * 3072 + PB_V + hd * 64, GT2 + (size_t)hd * MT + q0 - 32, lane);
                i = 2; }
            for (int c = 31; c >= 0; --c, ++i) {
                if (base + qkb2 < -THR2) break;
                base += TC2[(b * 32 + c) * 8 + hd];
                if ((i & 3) == sp) attn_tile<true, false>(st, qr, gq + base, P.cache_k + ((size_t)(b * PAST + c * 32) * 8 + hd) * 64, P.cache_v + ((size_t)(b * PAST + c * 32) * 8 + hd) * 64, GC2 + (size_t)(b * 8 + hd) * PAST + c * 32, lane);
            }
            float lt = st.l + __shfl_xor(st.l, 32);
            float* mine = ldsf + wave * (34 * 64);
            mine[lane] = st.m; mine[64 + lane] = lt;
#pragma unroll
            for (int r = 0; r < 16; ++r) { mine[(2 + r) * 64 + lane] = st.o0[r]; mine[(18 + r) * 64 + lane] = st.o1[r]; }
            __syncthreads();
            if (sp == 0) {
                float mt = st.m;
#pragma unroll
                for (int s = 1; s < 4; ++s) mt = fmaxf(mt, ldsf[(wave + 2 * s) * (34 * 64) + lane]);
                const float a0 = __builtin_amdgcn_exp2f(st.m - mt);
                lt *= a0;
#pragma unroll
                for (int r = 0; r < 16; ++r) { st.o0[r] *= a0; st.o1[r] *= a0; }
#pragma unroll
                for (int s = 1; s < 4; ++s) { const float* oth = ldsf + (wave + 2 * s) * (34 * 64); const float as = __builtin_amdgcn_exp2f(oth[lane] - mt);
                    lt += as * oth[64 + lane];
#pragma unroll
                    for (int r = 0; r < 16; ++r) { st.o0[r] += as * oth[(2 + r) * 64 + lane]; st.o1[r] += as * oth[(18 + r) * 64 + lane]; } }
                attn_finish(st, lt, PB, Z, q0, hd, lane);
            }
            __syncthreads();
        }
        for (int unit = bid; unit < MT / 64; unit += G) {
            bf16* Dl = (bf16*)lds;
            const int r0 = unit * 64; const bool pr = r0 < SEQ; const int bb = pr ? 0 : (r0 - SEQ) >> 6;
            {
                const int c = tid, w = 2 << (c >> 7);
                const bf16* ucol = PB + PB_U + c;
                const float* hist = P.state_pool + (size_t)bb * 15 * 512 + c;
                const float invw = 1.0f / (float)w;
                float S = 0.f;
                for (int k = 1; k < w; ++k) { const int l = -k; float uv;
                    if (pr) { const int m = r0 + l; uv = (m >= 0) ? bf2f(ucol[(size_t)m * 3072]) : 0.f; } else uv = hist[(15 + l) * 512];
                    S += uv; }
                for (int t = 0; t < 64; ++t) {
                    const float u = bf2f(ucol[(size_t)(r0 + t) * 3072]);
                    S += u;
                    float mean;
                    if (pr) { const int pos = r0 + t; mean = (pos + 1 < w) ? S / (float)(pos + 1) : S * invw; } else mean = S * invw;
                    Dl[t * 520 + c] = (bf16)f2bf(mean - u);
                    const int l = t - w + 1; float ov;
                    if (l >= 0) ov = bf2f(ucol[(size_t)(r0 + l) * 3072]);
                    else if (pr) { const int m = r0 + l; ov = (m >= 0) ? bf2f(ucol[(size_t)m * 3072]) : 0.f; }
                    else ov = hist[(15 + l) * 512];
                    S -= ov;
                }
                if (unit == SEQ / 64 - 1) { for (int t = 0; t < 15; ++t) P.out[O_PP + (size_t)t * 512 + c] = bf2f(ucol[(size_t)(SEQ - 15 + t) * 3072]); }
                if (!pr) { for (int t = 0; t < 15; ++t) P.out[O_PS + (size_t)(bb * 15 + t) * 512 + c] = bf2f(ucol[(size_t)(r0 + 49 + t) * 3072]); }
            }
            __syncthreads();
            {
                const int rb = wave & 1, g = wave >> 1;
                f32x16 acc[4];
#pragma unroll
                for (int nb = 0; nb < 4; ++nb) acc[nb] = f32x16{};
#pragma unroll
                for (int ks = 0; ks < 8; ++ks) { const bf16x8 a = *(const bf16x8*)(Dl + (32 * rb + r32) * 520 + g * 128 + 16 * ks + 8 * h2);
#pragma unroll
                    for (int nb = 0; nb < 4; ++nb) { const bf16x8 bw = *(const bf16x8*)(WP + ((size_t)(g * 128 + 32 * nb + r32)) * 128 + 16 * ks + 8 * h2);
                        acc[nb] = __builtin_amdgcn_mfma_f32_32x32x16_bf16(a, bw, acc[nb], 0, 0, 0); } }
#pragma unroll
                for (int nb = 0; nb < 4; ++nb) { const int j = g * 128 + 32 * nb + r32; const float ps = P.pool_scale[j];
#pragma unroll
                    for (int r = 0; r < 16; ++r) { const int m = r0 + 32 * rb + (r & 3) + 8 * (r >> 2) + 4 * h2;
                        const float pg = bf2f(PB[(size_t)m * 3072 + PB_PG + j]);
                        Z[(size_t)m * 1024 + 512 + j] = (bf16)f2bf(acc[nb][r] * ps * silu_f(pg)); } }
            }
            __syncthreads();
        }
        for (;;) {
            unsigned u = 0; if (lane == 0) u = atomicAdd(cnt, 1u); u = __builtin_amdgcn_readfirstlane(u);
            if (u >= 4096u) break;
            const int cq = (int)(u >> 3), hd = (int)(u & 7), q0 = cq * 32;
            const float qm2 = __uint_as_float(qkmax[2 * hd]) + __uint_as_float(qkmax[2 * hd + 1]);
            const float km2 = __uint_as_float(qkmax[16 + 2 * hd]) + __uint_as_float(qkmax[16 + 2 * hd + 1]);
            const float qkb2 = 2.0f * 1.02f * SC2 * sqrtf(qm2 * km2);
            bf16x8 qr[4]; load_q(qr, PB, q0, hd, lane);
            const float gq = GT2[(size_t)hd * MT + q0 + r32];
            AttnState st; st.m = -INFINITY; st.l = 0.f; st.o0 = f32x16{}; st.o1 = f32x16{};
            attn_tile<false, true>(st, qr, gq, PB + (size_t)q0 * 3072 + PB_K + hd * 64, PB + (size_t)q0 * 3072 + PB_V + hd * 64, GT2 + (size_t)hd * MT + q0, lane);
            float base = 0.f;
            for (int ck = cq - 1; ck >= 0; --ck) {
                if (base + qkb2 < -THR2) break;
                base += TP2[ck * 8 + hd];
                attn_tile<false, false>(st, qr, gq + base, PB + (size_t)ck * 32 * 3072 + PB_K + hd * 64, PB + (size_t)ck * 32 * 3072 + PB_V + hd * 64, GT2 + (size_t)hd * MT + ck * 32, lane);
            }
            attn_finish(st, st.l + __shfl_xor(st.l, 32), PB, Z, q0, hd, lane);
        }
    }
    grid.sync();

    {
        pg8::Gemm g{Z, WOUT, MT, DM, DM}; pg8::StaticOrder S; S.init(MT, DM, G, bid);
        pg8::EpiMerge E{P.x_prompt, P.x_sample, P.out + O_YP, P.out + O_YS, adaM, P.b_ada, rowss};
        pg8::gemm_phase<pg8::EpiMerge, pg8::StaticOrder, true, true>((LAS unsigned char*)lds, g, S, E);
    }
    grid.sync();

    {
        const int gw = bid * 8 + wave, NGW = G * 8;
        for (int m = gw; m < MT; m += NGW) {
            const float rs = 1.0f / sqrtf(__hip_atomic_load(rowss + m, __ATOMIC_RELAXED, __HIP_MEMORY_SCOPE_AGENT) * (1.0f / DM) + EPS);
            float* yr = P.out + (size_t)m * DM;
#pragma unroll
            for (int j = 0; j < 4; ++j) { const int col = 4 * lane + 256 * j; const f32x4 v = *(const f32x4*)(yr + col), g = *(const f32x4*)(P.final_g + col); *(f32x4*)(yr + col) = v * rs * g; }
        }
    }
}

extern "C" void kernel_launch(void* const* d_in, const int* in_sizes, int n_in, void* d_out, int out_size, void* d_ws, size_t ws_size, hipStream_t stream) {
    static int grid = 0;
    if (grid == 0) {
        if (n_in != 17 || (size_t)out_size != O_END || ws_size < WS_END) { fprintf(stderr, "kernel_launch: unexpected problem shape (n_in %d, out %d, ws %zu)\n", n_in, out_size, ws_size); grid = -1; return; }
        int dev = 0, cus = 0, per_cu = 0;
        hipGetDevice(&dev); hipDeviceGetAttribute(&cus, hipDeviceAttributeMultiprocessorCount, dev);
        hipFuncSetAttribute((const void*)fox_pool_fwd, hipFuncAttributeMaxDynamicSharedMemorySize, LDS_BYTES);
        hipOccupancyMaxActiveBlocksPerMultiprocessor(&per_cu, (const void*)fox_pool_fwd, 512, LDS_BYTES);
        (void)hipGetLastError();
        if (per_cu < 1) { fprintf(stderr, "kernel_launch: occupancy query reports %d blocks per CU\n", per_cu); per_cu = 1; }
        grid = cus * 1;
    }
    if (grid < 0) return;
    hipMemsetAsync((char*)d_ws + WS_CTL, 0, CTL_BYTES, stream);
    Params p{};
    const float** pp = (const float**)&p;
    for (int i = 0; i < 17; ++i) pp[i] = (const float*)d_in[i];
    p.out = (float*)d_out; p.ws = (unsigned char*)d_ws;
    void* args[] = {&p};
    hipError_t e = hipLaunchCooperativeKernel((const void*)fox_pool_fwd, dim3(grid), dim3(512), args, LDS_BYTES, stream);
    if (e != hipSuccess) fprintf(stderr, "cooperative launch failed: %s (grid %d)\n", hipGetErrorString(e), grid);
}
```

```cpp
#include <hip/hip_runtime.h>
#include <hip/hip_cooperative_groups.h>
#include <cstdio>
#include <cstdint>
namespace cg = cooperative_groups;
namespace pg8 {
#define PG8_LAS __attribute__((address_space(3)))
typedef unsigned short bf16_t;
typedef short bf16x8 __attribute__((ext_vector_type(8)));
typedef float f32x4 __attribute__((ext_vector_type(4)));
typedef unsigned u32x4 __attribute__((ext_vector_type(4)));
constexpr int BM = 256, BK = 64, HALF = 128, HTB = HALF * BK * 2  , STAGE_BYTES = 8 * HTB, NXCD = 8, WGM = 8;

__host__ __device__ __forceinline__ int lds_byte(int r, int c) { const int st = (r >> 4) * 2 + (c >> 5), rr = r & 15, cc = c & 31, ob = rr * 64 + cc * 2; return st * 1024 + (ob ^ (((ob >> 9) & 1) << 5)); }
__host__ __device__ __forceinline__ void stage_rc(int b, int& R, int& C) { const int st = b / 1024, sb = b % 1024, swz = sb ^ (((sb >> 9) & 1) << 5); R = (st >> 1) * 16 + swz / 64; C = (st & 1) * 32 + (swz % 64) / 2; }
__host__ __device__ __forceinline__ int perm32(int rho) { const int n = rho >> 4, i = rho & 15; return 8 * (i >> 2) + 4 * n + (i & 3); }

struct Unit { int pm, pn; };
struct Gemm { const bf16_t* A; const bf16_t* Bt; int M, N, K; };

struct StaticOrder {
    int nM, nN, nwg, G, c, rep = 1;
    __host__ __device__ void init(int M, int N, int G_, int c_) { nM = M / BM; nN = N / BM; nwg = nM * nN; G = G_; c = c_; }
    __host__ __device__ bool next(int i, Unit& u) const {
        const long L = (long)i * G + c; if (L >= (long)nwg * rep) return false;
        int wgid = (int)(L % nwg); { const int q = nwg / NXCD, r = nwg % NXCD, xcd = wgid % NXCD, off = wgid / NXCD; wgid = (xcd < r ? xcd * (q + 1) : r * (q + 1) + (xcd - r) * q) + off; }
        const int nig = WGM * nN, gid = wgid / nig, fm = gid * WGM, gsz = (nM - fm) < WGM ? (nM - fm) : WGM;
        u.pm = fm + ((wgid % nig) % gsz); u.pn = (wgid % nig) / gsz; return true;
    }
    __device__ __forceinline__ void a_ready(const Unit&) const {}
    __device__ __forceinline__ void done(const Unit&) const {}
};

__device__ __forceinline__ unsigned cvt_pk_bf16(float lo, float hi) { unsigned r; asm volatile("v_cvt_pk_bf16_f32 %0, %1, %2" : "=v"(r) : "v"(lo), "v"(hi)); return r; }

struct EpiProj {
    static constexpr bool PERM = true, AFTER_DRAIN = false;
    bf16_t* PB; float* out; unsigned* qkmax;
    __device__ __forceinline__ void operator()(const f32x4 (&acc)[2][2][4][2], const Unit& u, int wr, int wc, int fr, int fq) const {
        const int row0 = u.pm * BM + wr * 64 + fr; const int col0 = u.pn * BM + wc * 32 + 8 * fq;
#pragma unroll
        for (int ai = 0; ai < 2; ++ai)
#pragma unroll
            for (int m = 0; m < 4; ++m) { bf16_t* rowp = PB + (size_t)(row0 + ai * HALF + m * 16) * 3072 + col0;
#pragma unroll
                for (int bj = 0; bj < 2; ++bj) { const f32x4 v0 = acc[ai][bj][m][0], v1 = acc[ai][bj][m][1];
                    u32x4 w; w.x = cvt_pk_bf16(v0[0], v0[1]); w.y = cvt_pk_bf16(v0[2], v0[3]); w.z = cvt_pk_bf16(v1[0], v1[1]); w.w = cvt_pk_bf16(v1[2], v1[3]);
                    *(u32x4*)(rowp + bj * HALF) = w; } }
        if (u.pn >= 2 && u.pn < 6) {
            const size_t obase = (u.pn < 4) ? (u.pm < 64 ? (size_t)17301504 : (size_t)34217472) : (u.pm < 64 ? (size_t)25690112 : (size_t)34479616);
            float* base = out + obase;
            const int rowl = (u.pm < 64 ? u.pm : u.pm - 64) * BM + wr * 64 + fr; const int colf = (u.pn & 1) * BM + wc * 32 + 8 * fq;
#pragma unroll
            for (int ai = 0; ai < 2; ++ai)
#pragma unroll
                for (int m = 0; m < 4; ++m) { float* rp = base + (size_t)(rowl + ai * HALF + m * 16) * 512 + colf;
#pragma unroll
                    for (int bj = 0; bj < 2; ++bj) { *(f32x4*)(rp + bj * HALF) = acc[ai][bj][m][0]; *(f32x4*)(rp + bj * HALF + 4) = acc[ai][bj][m][1]; } }
        }
        if (u.pn < 4) {
#pragma unroll
            for (int bj = 0; bj < 2; ++bj) { float mx = 0.f;
#pragma unroll
                for (int ai = 0; ai < 2; ++ai)
#pragma unroll
                    for (int m = 0; m < 4; ++m) { const f32x4 a = acc[ai][bj][m][0], b = acc[ai][bj][m][1];
                        float s = (a[0] * a[0] + a[1] * a[1]) + (a[2] * a[2] + a[3] * a[3]) + (b[0] * b[0] + b[1] * b[1]) + (b[2] * b[2] + b[3] * b[3]);
                        s += __shfl_xor(s, 16); s += __shfl_xor(s, 32); mx = fmaxf(mx, s); }
                mx = fmaxf(mx, __shfl_xor(mx, 1)); mx = fmaxf(mx, __shfl_xor(mx, 2)); mx = fmaxf(mx, __shfl_xor(mx, 4)); mx = fmaxf(mx, __shfl_xor(mx, 8));
                if (fr == 0 && fq == 0) atomicMax(qkmax + (u.pn * 8 + bj * 4 + wc), __float_as_uint(mx)); }
        }
    }
};
struct EpiMerge {
    static constexpr bool PERM = true, AFTER_DRAIN = false;
    const float* xp; const float* xs; float* yp; float* ys; const float* gate; const float* final_g; float* rowss; unsigned* pcnt;
    __device__ __forceinline__ void operator()(f32x4 (&acc)[2][2][4][2], const Unit& u, int wr, int wc, int fr, int fq) const {
        const bool pr = u.pm < 64; const int rowl = (pr ? u.pm : u.pm - 64) * BM + wr * 64 + fr;
        const float* xb = pr ? xp : xs; float* yb = pr ? yp : ys; const int col0 = u.pn * BM + wc * 32 + 8 * fq;
#pragma unroll
        for (int ai = 0; ai < 2; ++ai) {
            const int bi = pr ? 0 : 1 + (u.pm - 64) * 4 + 2 * ai + wr;
            f32x4 gt[2][2];
#pragma unroll
            for (int bj = 0; bj < 2; ++bj)
#pragma unroll
                for (int n = 0; n < 2; ++n) gt[bj][n] = *(const f32x4*)(gate + bi * 1024 + col0 + bj * HALF + 4 * n);
#pragma unroll
            for (int mp = 0; mp < 2; ++mp) {
            f32x4 xv[2][2][2];
#pragma unroll
            for (int m2 = 0; m2 < 2; ++m2) { const size_t off = (size_t)(rowl + ai * HALF + (2 * mp + m2) * 16) * 1024 + col0;
#pragma unroll
                for (int bj = 0; bj < 2; ++bj)
#pragma unroll
                    for (int n = 0; n < 2; ++n) xv[m2][bj][n] = *(const f32x4*)(xb + off + bj * HALF + 4 * n); }
#pragma unroll
            for (int m2 = 0; m2 < 2; ++m2) { const int m = 2 * mp + m2; float ss = 0.f;
#pragma unroll
                for (int bj = 0; bj < 2; ++bj)
#pragma unroll
                    for (int n = 0; n < 2; ++n) { const f32x4 o = xv[m2][bj][n] + gt[bj][n] * acc[ai][bj][m][n]; acc[ai][bj][m][n] = o; ss += (o[0] * o[0] + o[1] * o[1]) + (o[2] * o[2] + o[3] * o[3]); }
                ss += __shfl_xor(ss, 16); ss += __shfl_xor(ss, 32);
                if (fq == 0) (void)__hip_atomic_fetch_add(rowss + u.pm * BM + ai * HALF + wr * 64 + m * 16 + fr, ss, __ATOMIC_RELAXED, __HIP_MEMORY_SCOPE_AGENT); }
            asm volatile("" ::: "memory");
            }
        }
        asm volatile("s_waitcnt vmcnt(0)" ::: "memory");
        unsigned* pc = pcnt + 64 * (u.pm * 2 + wr);
        if (fr == 0 && fq == 0) (void)__hip_atomic_fetch_add(pc, 1u, __ATOMIC_RELAXED, __HIP_MEMORY_SCOPE_AGENT);
        { unsigned sp = 0; while ((unsigned)__builtin_amdgcn_readfirstlane(__hip_atomic_load(pc, __ATOMIC_RELAXED, __HIP_MEMORY_SCOPE_AGENT)) < 16u) { __builtin_amdgcn_s_sleep(2); if (++sp > (1u << 22)) break; } }
        asm volatile("" ::: "memory");
#pragma unroll
        for (int ai = 0; ai < 2; ++ai) {
            f32x4 fg[2][2];
#pragma unroll
            for (int bj = 0; bj < 2; ++bj)
#pragma unroll
                for (int n = 0; n < 2; ++n) fg[bj][n] = *(const f32x4*)(final_g + col0 + bj * HALF + 4 * n);
            float rs[4];
#pragma unroll
            for (int m = 0; m < 4; ++m) rs[m] = __hip_atomic_load(rowss + u.pm * BM + ai * HALF + wr * 64 + m * 16 + fr, __ATOMIC_RELAXED, __HIP_MEMORY_SCOPE_AGENT);
#pragma unroll
            for (int m = 0; m < 4; ++m) { const float r = 1.0f / sqrtf(rs[m] * (1.0f / 1024.0f) + 1e-6f); const size_t off = (size_t)(rowl + ai * HALF + m * 16) * 1024 + col0;
#pragma unroll
                for (int bj = 0; bj < 2; ++bj)
#pragma unroll
                    for (int n = 0; n < 2; ++n) *(f32x4*)(yb + off + bj * HALF + 4 * n) = acc[ai][bj][m][n] * r * fg[bj][n]; }
        }
    }
};
struct MergeOrder {
    int c, G;
    __device__ bool next(int i, Unit& u) const {
        const int L = i * G + c; if (L >= 264) return false;
        if (L < 256) { const int xcd = L & 7, off = L >> 3; u.pm = xcd * 8 + (off & 7); u.pn = off >> 3; } else { u.pm = 64 + ((L - 256) >> 2); u.pn = (L - 256) & 3; }
        return true; }
    __device__ __forceinline__ void a_ready(const Unit&) const {}
    __device__ __forceinline__ void done(const Unit&) const {}
};

template <class Epi, class Sched, bool ALIGN_EPI = false, bool SP2 = false>
__device__ __forceinline__ void gemm_phase(PG8_LAS unsigned char* lds, const Gemm g, const Sched& S, const Epi& E) {
    const int tid = threadIdx.x, wid = __builtin_amdgcn_readfirstlane(tid >> 6), lane = tid & 63, wr = wid >> 2, wc = wid & 3, fr = lane & 15, fq = lane >> 4;
    const int K = g.K, nt = K / BK;
    unsigned voffA[2], voffB[2];
#pragma unroll
    for (int i = 0; i < 2; ++i) { int R, C; stage_rc(tid * 16 + i * 8192, R, C); const int Rb = Epi::PERM ? ((R & ~31) + perm32(R & 31)) : R;
        voffA[i] = (unsigned)(R * K + C) * 2u; voffB[i] = (unsigned)(Rb * K + C) * 2u; }
    const size_t kstep = (size_t)(BK * 2);
    const size_t hstep = (size_t)HALF * K * 2;
    const size_t tstep = 2 * hstep;
    const unsigned ldsw = (unsigned)wid * 1024u;
    const int aoff = lds_byte(wr * 64 + fr, fq * 8), boff = lds_byte(wc * 32 + fr, fq * 8);
#define PG8_SA(b, h) (((b) * 2 + (h)) * HTB)
#define PG8_SB(b, h) ((4 + (b) * 2 + (h)) * HTB)
#define PG8_STAGE(bufoff, gbase, voff) do { _Pragma("unroll") for (int _i = 0; _i < 2; ++_i) \
        __builtin_amdgcn_global_load_lds((const unsigned*)((const char*)(gbase) + (voff)[_i]), (PG8_LAS unsigned*)(lds + (bufoff) + ldsw + _i * 8192), 16, 0, 0); } while (0)
#define PG8_LDA(dst, b, h) do { _Pragma("unroll") for (int m = 0; m < 4; ++m) _Pragma("unroll") for (int k = 0; k < 2; ++k) dst[m][k] = *(const PG8_LAS bf16x8*)(lds + PG8_SA(b, h) + aoff + m * 2048 + k * 1024); } while (0)
#define PG8_LDB(dst, b, h) do { _Pragma("unroll") for (int n = 0; n < 2; ++n) _Pragma("unroll") for (int k = 0; k < 2; ++k) dst[n][k] = *(const PG8_LAS bf16x8*)(lds + PG8_SB(b, h) + boff + n * 2048 + k * 1024); } while (0)
#define PG8_MMA(ai, bj, At, Bt) do { __builtin_amdgcn_s_setprio(1); _Pragma("unroll") for (int m = 0; m < 4; ++m) _Pragma("unroll") for (int n = 0; n < 2; ++n) _Pragma("unroll") for (int k = 0; k < 2; ++k) \
        acc[ai][bj][m][n] = __builtin_amdgcn_mfma_f32_16x16x32_bf16(Bt[n][k], At[m][k], acc[ai][bj][m][n], 0, 0, 0); __builtin_amdgcn_s_setprio(0); } while (0)
#define PG8_WAIT_V(n) asm volatile("s_waitcnt vmcnt(" #n ")" ::: "memory")
#define PG8_WAIT_L(n) asm volatile("s_waitcnt lgkmcnt(" #n ")" ::: "memory")
#define PG8_BAR __builtin_amdgcn_s_barrier()
#define PG8_SCHED __builtin_amdgcn_sched_barrier(0)
    Unit cur, nxt; int ui = 0;
    if (!S.next(0, cur)) return;
    f32x4 acc[2][2][4][2];
#pragma unroll
    for (int a = 0; a < 2; ++a)
#pragma unroll
        for (int b = 0; b < 2; ++b)
#pragma unroll
            for (int m = 0; m < 4; ++m)
#pragma unroll
                for (int n = 0; n < 2; ++n) acc[a][b][m][n] = (f32x4){0.f, 0.f, 0.f, 0.f};
    bf16x8 At[4][2], B0[2][2], B1[2][2];
    const char* cA = (const char*)g.A + (size_t)cur.pm * tstep; const char* cB = (const char*)g.Bt + (size_t)cur.pn * tstep;
    S.a_ready(cur);
    if constexpr (SP2) {
        PG8_STAGE(PG8_SB(0, 0), cB, voffB); PG8_STAGE(PG8_SB(0, 1), cB + hstep, voffB); PG8_STAGE(PG8_SA(0, 0), cA, voffA); PG8_STAGE(PG8_SA(0, 1), cA + hstep, voffA);
        if (wr == 1) PG8_BAR;
        PG8_WAIT_V(2); PG8_BAR;
        PG8_STAGE(PG8_SB(1, 0), cB + kstep, voffB); PG8_STAGE(PG8_SA(1, 0), cA + kstep, voffA); PG8_STAGE(PG8_SB(1, 1), cB + hstep + kstep, voffB);
        PG8_WAIT_V(6); PG8_BAR;
    } else {
        PG8_STAGE(PG8_SB(0, 0), cB, voffB); PG8_STAGE(PG8_SA(0, 0), cA, voffA); PG8_STAGE(PG8_SB(0, 1), cB + hstep, voffB); PG8_STAGE(PG8_SA(0, 1), cA + hstep, voffA);
        if (wr == 1) PG8_BAR;
        PG8_WAIT_V(4); PG8_BAR;
        PG8_STAGE(PG8_SB(1, 0), cB + kstep, voffB); PG8_STAGE(PG8_SA(1, 0), cA + kstep, voffA); PG8_STAGE(PG8_SB(1, 1), cB + hstep + kstep, voffB);
        PG8_WAIT_V(6); PG8_BAR;
    }
    for (;;) {
        const bool has_next = S.next(ui + 1, nxt);
        const char* nA = has_next ? (const char*)g.A + (size_t)nxt.pm * tstep : cA; const char* nB = has_next ? (const char*)g.Bt + (size_t)nxt.pn * tstep : cB;
        for (int t = 0; t < nt; t += 2) {
            const bool last = (t == nt - 2);
            const char* a1 = cA + (size_t)(t + 1) * kstep;
            const char* a2 = last ? nA : cA + (size_t)(t + 2) * kstep; const char* b2 = last ? nB : cB + (size_t)(t + 2) * kstep;
            const char* a3 = a2 + kstep; const char* b3 = b2 + kstep;
            if (last && has_next) S.a_ready(nxt);
            if constexpr (SP2) {
            PG8_LDB(B0, 0, 0); PG8_LDB(B1, 0, 1); PG8_SCHED; PG8_LDA(At, 0, 0); PG8_STAGE(PG8_SA(1, 1), a1 + hstep, voffA);
            PG8_WAIT_V(8); PG8_WAIT_L(0); PG8_BAR; PG8_MMA(0, 0, At, B0); PG8_MMA(0, 1, At, B1); PG8_BAR; PG8_SCHED;
            PG8_LDA(At, 0, 1); PG8_STAGE(PG8_SB(0, 0), b2, voffB); PG8_STAGE(PG8_SB(0, 1), b2 + hstep, voffB); PG8_STAGE(PG8_SA(0, 0), a2, voffA);
            PG8_WAIT_V(8); PG8_WAIT_L(0); PG8_BAR; PG8_MMA(1, 0, At, B0); PG8_MMA(1, 1, At, B1); PG8_BAR; PG8_SCHED;
            PG8_LDB(B0, 1, 0); PG8_LDB(B1, 1, 1); PG8_SCHED; PG8_LDA(At, 1, 0); PG8_STAGE(PG8_SA(0, 1), a2 + hstep, voffA);
            PG8_WAIT_V(8); PG8_WAIT_L(0); PG8_BAR; PG8_MMA(0, 0, At, B0); PG8_MMA(0, 1, At, B1); PG8_BAR; PG8_SCHED;
            PG8_LDA(At, 1, 1); PG8_STAGE(PG8_SB(1, 0), b3, voffB); PG8_STAGE(PG8_SB(1, 1), b3 + hstep, voffB); PG8_STAGE(PG8_SA(1, 0), a3, voffA);
            PG8_WAIT_V(8); PG8_WAIT_L(0); PG8_BAR; PG8_MMA(1, 0, At, B0); PG8_MMA(1, 1, At, B1); PG8_BAR; PG8_SCHED;
            } else {
            PG8_LDB(B0, 0, 0); PG8_SCHED; PG8_LDA(At, 0, 0); PG8_STAGE(PG8_SA(1, 1), a1 + hstep, voffA);
            PG8_WAIT_L(8); PG8_BAR; PG8_WAIT_L(0); PG8_MMA(0, 0, At, B0); PG8_BAR; PG8_SCHED;
            PG8_LDB(B1, 0, 1); PG8_STAGE(PG8_SB(0, 0), b2, voffB);
            PG8_BAR; PG8_WAIT_L(0); PG8_MMA(0, 1, At, B1); PG8_BAR;
            PG8_LDA(At, 0, 1); PG8_STAGE(PG8_SA(0, 0), a2, voffA);
            PG8_BAR; PG8_WAIT_L(0); PG8_MMA(1, 0, At, B0); PG8_BAR; PG8_SCHED;
            PG8_STAGE(PG8_SB(0, 1), b2 + hstep, voffB);
            PG8_WAIT_V(6); PG8_BAR; PG8_MMA(1, 1, At, B1); PG8_BAR;
            PG8_LDB(B0, 1, 0); PG8_SCHED; PG8_LDA(At, 1, 0); PG8_STAGE(PG8_SA(0, 1), a2 + hstep, voffA);
            PG8_WAIT_L(8); PG8_BAR; PG8_WAIT_L(0); PG8_MMA(0, 0, At, B0); PG8_BAR; PG8_SCHED;
            PG8_LDB(B1, 1, 1); PG8_STAGE(PG8_SB(1, 0), b3, voffB);
            PG8_BAR; PG8_WAIT_L(0); PG8_MMA(0, 1, At, B1); PG8_BAR;
            PG8_LDA(At, 1, 1); PG8_STAGE(PG8_SA(1, 0), a3, voffA);
            PG8_BAR; PG8_WAIT_L(0); PG8_MMA(1, 0, At, B0); PG8_BAR; PG8_SCHED;
            PG8_STAGE(PG8_SB(1, 1), b3 + hstep, voffB);
            PG8_WAIT_V(6); PG8_BAR; PG8_MMA(1, 1, At, B1); PG8_BAR;
            }
        }
        if constexpr (ALIGN_EPI) { if (wr == 0) PG8_BAR; }
        if constexpr (!Epi::AFTER_DRAIN) { E(acc, cur, wr, wc, fr, fq); S.done(cur); }
        if (!has_next) break;
#pragma unroll
        for (int a = 0; a < 2; ++a)
#pragma unroll
            for (int b = 0; b < 2; ++b)
#pragma unroll
                for (int m = 0; m < 4; ++m)
#pragma unroll
                    for (int n = 0; n < 2; ++n) acc[a][b][m][n] = (f32x4){0.f, 0.f, 0.f, 0.f};
        cur = nxt; cA = nA; cB = nB; ++ui;
        if constexpr (ALIGN_EPI) { if (wr == 1) PG8_BAR; }
    }
    PG8_WAIT_V(0);
    if constexpr (!ALIGN_EPI) { if (wr == 0) PG8_BAR; }
    PG8_BAR;
    if constexpr (Epi::AFTER_DRAIN) { E.fused(acc, cur, wr, wc, fr, fq, lds, wid, lane); S.done(cur); }
#undef PG8_SA
#undef PG8_SB
#undef PG8_STAGE
#undef PG8_LDA
#undef PG8_LDB
#undef PG8_MMA
#undef PG8_WAIT_V
#undef PG8_WAIT_L
#undef PG8_BAR
#undef PG8_SCHED
}
}

#ifndef REP_P1
#define REP_P1 1
#endif
#ifndef REP_P2
#define REP_P2 1
#endif
#ifndef REP_P3
#define REP_P3 1
#endif
#ifndef REP_P4
#define REP_P4 1
#endif
#ifndef XSYNC
#define XSYNC 0
#endif
typedef unsigned short bf16;
typedef short bf16x8 __attribute__((ext_vector_type(8)));
typedef float f32x4 __attribute__((ext_vector_type(4)));
typedef float f32x16 __attribute__((ext_vector_type(16)));
typedef unsigned u32x4 __attribute__((ext_vector_type(4)));
typedef unsigned u32x2 __attribute__((ext_vector_type(2)));
#define LAS __attribute__((address_space(3)))
constexpr int DM = 1024, SEQ = 16384, NSAMP = 512, MT = SEQ + NSAMP, INC = 3080, NPJ = 3072, PAST = 1024;
constexpr int NCHUNK = MT / 32;
constexpr float EPS = 1e-6f, LOG2E = 1.4426950408889634f;
constexpr float SC2 = 0.125f * LOG2E;
constexpr float THR2 = 40.0f * LOG2E;
constexpr size_t MiB = 1u << 20;
constexpr size_t WS_CTL = 0, CTL_BYTES = 1 * MiB;
constexpr size_t WS_WIN = 2 * MiB, WS_WOUT = 8 * MiB, WS_WP = 10 * MiB, WS_GT = 11 * MiB, WS_TP = 12 * MiB, WS_GC = 12 * MiB + 65536, WS_TC = 12 * MiB + 524288;
constexpr size_t WS_ADAP = 13 * MiB  , WS_ADAG = 15 * MiB  ;
constexpr size_t WS_XN = 16 * MiB, WS_PB = 50 * MiB, WS_Z = 150 * MiB, WS_END = 184 * MiB;
constexpr int CW_ROWSS = 32768, CW_QKMAX = 49920, CW_KCMAX = 49984, CW_CNT = 50048, CW_PCNT = 51200  , CW_BAR = 65536  ;
constexpr int PB_Q = 0, PB_K = 512, PB_V = 1024, PB_AG = 1536, PB_U = 2048, PB_PG = 2560;
constexpr int LDS_BYTES = 148480, MISC_OFF = 147456;

struct Params {
    const float *x_prompt, *x_sample, *c_prompt, *c_sample, *cache_k, *cache_v, *cache_logf, *state_pool, *norm_g, *w_ada, *b_ada, *w_in, *b_f, *w_pool, *pool_scale, *w_out, *final_g;
    float* out; unsigned char* ws;
};
constexpr size_t O_YP = 0, O_YS = O_YP + (size_t)SEQ * DM, O_KP = O_YS + (size_t)NSAMP * DM, O_VP = O_KP + (size_t)SEQ * 512, O_LFP = O_VP + (size_t)SEQ * 512,
                 O_PP = O_LFP + (size_t)SEQ * 8, O_KS = O_PP + 15 * 512, O_VS = O_KS + (size_t)NSAMP * 512, O_LFS = O_VS + (size_t)NSAMP * 512, O_PS = O_LFS + (size_t)NSAMP * 8, O_END = O_PS + 8 * 15 * 512;

__device__ __forceinline__ unsigned f2bf(float f) { unsigned u = __builtin_bit_cast(unsigned, f); return (u + 0x7fffu + ((u >> 16) & 1u)) >> 16; }
__device__ __forceinline__ unsigned pk2(float lo, float hi) { return f2bf(lo) | (f2bf(hi) << 16); }
__device__ __forceinline__ float bf2f(unsigned short b) { return __uint_as_float(((unsigned)b) << 16); }
__device__ __forceinline__ float wave_sum(float v) {
#pragma unroll
    for (int o = 1; o < 64; o <<= 1) v += __shfl_xor(v, o);
    return v;
}
__device__ __forceinline__ float silu_f(float v) { return v * __builtin_amdgcn_rcpf(1.0f + __expf(-v)); }

__device__ __forceinline__ void tr_item(const float* W, int ldw, int k0, int c0, bf16* WT, int ldt, int n0, float* scr, int lane) {
#pragma unroll 8
    for (int i = 0; i < 32; ++i) { const int kk = 2 * i + (lane >> 5); scr[kk * 33 + (lane & 31)] = W[(size_t)(k0 + kk) * ldw + c0 + (lane & 31)]; }
    asm volatile("s_waitcnt lgkmcnt(0)" ::: "memory");
    const int c = lane & 7;
#pragma unroll
    for (int j = 0; j < 4; ++j) { const int n = (lane >> 3) + 8 * j; const float* s = scr + (8 * c) * 33 + n;
        u32x4 o; o.x = pk2(s[0 * 33], s[1 * 33]); o.y = pk2(s[2 * 33], s[3 * 33]); o.z = pk2(s[4 * 33], s[5 * 33]); o.w = pk2(s[6 * 33], s[7 * 33]);
        *(u32x4*)(WT + (size_t)(n0 + n) * ldt + k0 + 8 * c) = o; }
    asm volatile("s_waitcnt lgkmcnt(0)" ::: "memory");
}

struct AttnState { float m, l; f32x16 o0, o1; };
__device__ __forceinline__ unsigned cvtpk(float lo, float hi) { typedef float f2 __attribute__((ext_vector_type(2))); typedef __bf16 b2 __attribute__((ext_vector_type(2))); f2 v = {lo, hi}; b2 b = __builtin_convertvector(v, b2); return __builtin_bit_cast(unsigned, b); }

template <bool F32SRC, bool DIAG>
__device__ __forceinline__ void attn_tile(AttnState& st, const bf16x8 (&qr)[4], float gqb, const void* kb, const void* vb, const float* g2, int lane) {
    const int r32 = lane & 31, h2 = lane >> 5;
    bf16x8 kf[4]; bf16x8 va[2][2];
    if constexpr (!F32SRC) {
        const bf16* kp = (const bf16*)kb + (size_t)r32 * 3072 + 8 * h2;
#pragma unroll
        for (int d0 = 0; d0 < 4; ++d0) kf[d0] = *(const bf16x8*)(kp + 16 * d0);
        const bf16* vp = (const bf16*)vb + r32;
#pragma unroll
        for (int db = 0; db < 2; ++db)
#pragma unroll
            for (int s = 0; s < 2; ++s) { u32x4 w;
#pragma unroll
                for (int jj = 0; jj < 4; ++jj) { const int r0 = 16 * s + 8 * (jj >> 1) + 4 * h2 + 2 * (jj & 1);
                    const unsigned lo = vp[(size_t)r0 * 3072 + 32 * db], hi = vp[(size_t)(r0 + 1) * 3072 + 32 * db]; w[jj] = lo | (hi << 16); }
                va[db][s] = __builtin_bit_cast(bf16x8, w); }
    } else {
        const float* kp = (const float*)kb + (size_t)r32 * 512 + 8 * h2;
#pragma unroll
        for (int d0 = 0; d0 < 4; ++d0) { const f32x4 a = *(const f32x4*)(kp + 16 * d0), b = *(const f32x4*)(kp + 16 * d0 + 4);
            u32x4 w; w.x = cvtpk(a[0], a[1]); w.y = cvtpk(a[2], a[3]); w.z = cvtpk(b[0], b[1]); w.w = cvtpk(b[2], b[3]); kf[d0] = __builtin_bit_cast(bf16x8, w); }
        const float* vp = (const float*)vb + r32;
#pragma unroll
        for (int db = 0; db < 2; ++db)
#pragma unroll
            for (int s = 0; s < 2; ++s) { u32x4 w;
#pragma unroll
                for (int jj = 0; jj < 4; ++jj) { const int r0 = 16 * s + 8 * (jj >> 1) + 4 * h2 + 2 * (jj & 1);
                    w[jj] = cvtpk(vp[(size_t)r0 * 512 + 32 * db], vp[(size_t)(r0 + 1) * 512 + 32 * db]); }
                va[db][s] = __builtin_bit_cast(bf16x8, w); }
    }
    f32x4 gk[4];
#pragma unroll
    for (int i = 0; i < 4; ++i) gk[i] = *(const f32x4*)(g2 + 8 * i + 4 * h2);
    f32x16 S = {};
#pragma unroll
    for (int d0 = 0; d0 < 4; ++d0) S = __builtin_amdgcn_mfma_f32_32x32x16_bf16(kf[d0], qr[d0], S, 0, 0, 0);
    float mx = -INFINITY;
#pragma unroll
    for (int r = 0; r < 16; ++r) { float v = S[r] * SC2 + (gqb - gk[r >> 2][r & 3]);
        if (DIAG) { const int kvl = (r & 3) + 8 * (r >> 2) + 4 * h2; if (kvl > r32) v = -INFINITY; }
        S[r] = v; mx = fmaxf(mx, v); }
    mx = fmaxf(mx, __shfl_xor(mx, 32));
    const float mn = fmaxf(st.m, mx); const float alpha = __builtin_amdgcn_exp2f(st.m - mn); st.m = mn;
    float sum = 0.f;
#pragma unroll
    for (int r = 0; r < 16; ++r) { S[r] = __builtin_amdgcn_exp2f(S[r] - mn); sum += S[r]; }
    st.l = st.l * alpha + sum;
#pragma unroll
    for (int r = 0; r < 16; ++r) { st.o0[r] *= alpha; st.o1[r] *= alpha; }
    bf16x8 pb[2];
#pragma unroll
    for (int s = 0; s < 2; ++s) { u32x4 w; w.x = cvtpk(S[8 * s + 0], S[8 * s + 1]); w.y = cvtpk(S[8 * s + 2], S[8 * s + 3]); w.z = cvtpk(S[8 * s + 4], S[8 * s + 5]); w.w = cvtpk(S[8 * s + 6], S[8 * s + 7]); pb[s] = __builtin_bit_cast(bf16x8, w); }
    st.o0 = __builtin_amdgcn_mfma_f32_32x32x16_bf16(va[0][0], pb[0], st.o0, 0, 0, 0); st.o0 = __builtin_amdgcn_mfma_f32_32x32x16_bf16(va[0][1], pb[1], st.o0, 0, 0, 0);
    st.o1 = __builtin_amdgcn_mfma_f32_32x32x16_bf16(va[1][0], pb[0], st.o1, 0, 0, 0); st.o1 = __builtin_amdgcn_mfma_f32_32x32x16_bf16(va[1][1], pb[1], st.o1, 0, 0, 0);
}
__device__ __forceinline__ void attn_finish(const AttnState& st, float ltot, const bf16* PB, bf16* Z, int q0, int hd, int lane) {
    const int r32 = lane & 31, h2 = lane >> 5; const float inv = 1.0f / ltot;
    const bf16* agp = PB + (size_t)(q0 + r32) * 3072 + PB_AG + hd * 64 + 4 * h2; bf16* zp = Z + (size_t)(q0 + r32) * 1024 + hd * 64 + 4 * h2;
    u32x2 av[2][4];
#pragma unroll
    for (int db = 0; db < 2; ++db)
#pragma unroll
        for (int i = 0; i < 4; ++i) av[db][i] = *(const u32x2*)(agp + 32 * db + 8 * i);
#pragma unroll
    for (int db = 0; db < 2; ++db)
#pragma unroll
        for (int i = 0; i < 4; ++i) { const u32x2 a = av[db][i];
            const float a0 = __uint_as_float(a.x << 16), a1 = __uint_as_float(a.x & 0xffff0000u), a2 = __uint_as_float(a.y << 16), a3 = __uint_as_float(a.y & 0xffff0000u);
            const f32x16& o = db ? st.o1 : st.o0;
            u32x2 w; w.x = cvtpk(o[4 * i + 0] * inv * silu_f(a0), o[4 * i + 1] * inv * silu_f(a1)); w.y = cvtpk(o[4 * i + 2] * inv * silu_f(a2), o[4 * i + 3] * inv * silu_f(a3));
            *(u32x2*)(zp + 32 * db + 8 * i) = w; }
}
__device__ __forceinline__ void load_q(bf16x8 (&qr)[4], const bf16* PB, int q0, int hd, int lane) {
    const bf16* qp = PB + (size_t)(q0 + (lane & 31)) * 3072 + PB_Q + hd * 64 + 8 * (lane >> 5);
#pragma unroll
    for (int d0 = 0; d0 < 4; ++d0) qr[d0] = *(const bf16x8*)(qp + 16 * d0);
}

#define GAS __attribute__((address_space(1)))
#define RLX_AGENT __ATOMIC_RELAXED, __HIP_MEMORY_SCOPE_AGENT
#define XB_TMO      128
#define XB_XCNT(j)  (256  + 64 * (j))
#define XB_XSUB(j)  (1280 + 64 * (j))
#define XB_XGEN(j)  (2304 + 64 * (j))
#define XB_TOP      3328
#define XB_TOPGEN   3392
#define XCD_BAR_WORDS 3456
#define XB_SPIN_CAP (1u << 18)

__device__ __forceinline__ unsigned xb_ld(unsigned* p)              { return __hip_atomic_load(p, __ATOMIC_RELAXED, __HIP_MEMORY_SCOPE_AGENT); }
__device__ __forceinline__ unsigned xb_add(unsigned* p, unsigned v) { return __hip_atomic_fetch_add(p, v, __ATOMIC_RELAXED, __HIP_MEMORY_SCOPE_AGENT); }
__device__ __forceinline__ unsigned xb_xcc_id() { return (unsigned)__builtin_amdgcn_s_getreg((3 << 11) | 20) & 0xFu; }
#define XB_SPIN(cond, bar) do { unsigned _sp = 0; while (cond) { __builtin_amdgcn_s_sleep(1); \
    if ((++_sp & 255u) == 0u) { if (xb_ld(&(bar)[XB_TMO])) break; if (_sp > XB_SPIN_CAP) { atomicAdd(&(bar)[XB_TMO], 1u); break; } } } } while (0)

struct XcdBarrier {
    unsigned* bar; unsigned x;
    volatile LAS unsigned* st;
};

__device__ __forceinline__ XcdBarrier xcd_barrier_post(unsigned* bar, volatile LAS unsigned* st) {
    XcdBarrier b; b.bar = bar; b.x = xb_xcc_id(); b.st = st;
    if (threadIdx.x == 0) (void)xb_add(&bar[XB_XCNT(b.x)], 1u);
    return b;
}
__device__ __forceinline__ void xcd_barrier_complete(unsigned* bar, unsigned x, unsigned& nloc, unsigned& nx) {
    const unsigned G = gridDim.x * gridDim.y * gridDim.z;
    unsigned sum, cnt, mine, sp = 0u;
    for (;;) {
        sum = 0u; cnt = 0u; mine = 0u;
#pragma unroll
        for (unsigned j = 0; j < 16; ++j) { const unsigned c = xb_ld(&bar[XB_XCNT(j)]); sum += c; cnt += (c > 0u) ? 1u : 0u; mine = (j == x) ? c : mine; }
        if (sum == G) break;
        __builtin_amdgcn_s_sleep(1);
        if ((++sp & 255u) == 0u) { if (xb_ld(&bar[XB_TMO])) break; if (sp > XB_SPIN_CAP) { atomicAdd(&bar[XB_TMO], 1u); break; } }
    }
    nloc = mine > 0u ? mine : 1u; nx = cnt > 0u ? cnt : 1u;
}

__device__ __forceinline__ void xcd_barrier(const XcdBarrier& b) {
    asm volatile("s_waitcnt vmcnt(0)" ::: "memory");
    __syncthreads();
    if (threadIdx.x == 0) {
        unsigned* bar = b.bar;
        __builtin_amdgcn_s_waitcnt(0);
        unsigned nloc = b.st[0], nx = b.st[1];
        if (nloc == 0u) { xcd_barrier_complete(bar, b.x, nloc, nx); b.st[0] = nloc; b.st[1] = nx; }
        const unsigned old = xb_add(&bar[XB_XSUB(b.x)], 1u);
        const unsigned gen = old / nloc;
        if (old + 1u == (gen + 1u) * nloc) {
            __builtin_amdgcn_fence(__ATOMIC_RELEASE, "agent");
            asm volatile("s_waitcnt vmcnt(0)" ::: "memory");
            const unsigned og = xb_add(&bar[XB_TOP], 1u);
            const unsigned tg = og / nx;
            if (og + 1u == (tg + 1u) * nx) xb_add(&bar[XB_TOPGEN], 1u);
            else XB_SPIN(xb_ld(&bar[XB_TOPGEN]) == tg, bar);
            __builtin_amdgcn_fence(__ATOMIC_ACQUIRE, "agent");
            xb_add(&bar[XB_XGEN(b.x)], 1u);
            asm volatile("s_waitcnt vmcnt(0)" ::: "memory");
        } else {
            XB_SPIN(xb_ld(&bar[XB_XGEN(b.x)]) == gen, bar);
            __builtin_amdgcn_fence(__ATOMIC_ACQUIRE, "agent");
            asm volatile("s_waitcnt vmcnt(0)" ::: "memory");
        }
    }
    __syncthreads();
}

__global__ void __launch_bounds__(512, 2) fox_pool_fwd(Params P) {
    extern __shared__ __attribute__((aligned(16))) unsigned char lds[];
    cg::grid_group grid = cg::this_grid();
    const int tid = threadIdx.x, lane = tid & 63, wave = __builtin_amdgcn_readfirstlane(tid >> 6), G = gridDim.x, bid = blockIdx.x;
    unsigned char* ws = P.ws;
    float* ctlf = (float*)(ws + WS_CTL); unsigned* ctlu = (unsigned*)(ws + WS_CTL);
    float* adaP = (float*)(ws + WS_ADAP); float* adaG = (float*)(ws + WS_ADAG); float* rowss = ctlf + CW_ROWSS; unsigned* pcnt = ctlu + CW_PCNT; unsigned* qkmax = ctlu + CW_QKMAX; unsigned* kcmax = ctlu + CW_KCMAX; unsigned* cnt = ctlu + CW_CNT;
    bf16* WIN = (bf16*)(ws + WS_WIN); bf16* WOUT = (bf16*)(ws + WS_WOUT); bf16* WP = (bf16*)(ws + WS_WP);
    float* GT2 = (float*)(ws + WS_GT); float* TP2 = (float*)(ws + WS_TP); float* GC2 = (float*)(ws + WS_GC); float* TC2 = (float*)(ws + WS_TC);
    bf16* XN = (bf16*)(ws + WS_XN); bf16* PB = (bf16*)(ws + WS_PB); bf16* Z = (bf16*)(ws + WS_Z);
    float* ldsf = (float*)lds;
    volatile LAS unsigned* MISC = (volatile LAS unsigned*)((LAS unsigned char*)lds + MISC_OFF);
    if (tid < 16) MISC[tid] = 0u;
    __syncthreads();
    const XcdBarrier bar = xcd_barrier_post(ctlu + CW_BAR, MISC);

    for (int task = bid; task < 192; task += G) {
        const int cb = task % 12, kc = task / 12, k0 = kc * 64, n0 = cb * 256;
        float* Ssh = ldsf; float* part = ldsf + 1024;
        for (int i = tid; i < 576; i += 512) { const int b = i >> 6, kk = i & 63; const float c = (b == 0) ? P.c_prompt[k0 + kk] : P.c_sample[(b - 1) * 1024 + k0 + kk]; Ssh[i] = silu_f(c); }
        __syncthreads();
        f32x4 acc[9];
#pragma unroll
        for (int b = 0; b < 9; ++b) acc[b] = (f32x4){0.f, 0.f, 0.f, 0.f};
#pragma unroll
        for (int r = 0; r < 8; ++r) { const int k = wave * 8 + r; const f32x4 w = *(const f32x4*)(P.w_ada + (size_t)(k0 + k) * 3072 + n0 + 4 * lane);
#pragma unroll
            for (int b = 0; b < 9; ++b) acc[b] += Ssh[b * 64 + k] * w; }
#pragma unroll
        for (int b = 0; b < 9; ++b) *(f32x4*)(part + (wave * 9 + b) * 256 + 4 * lane) = acc[b];
        __syncthreads();
        for (int i = tid; i < 2304; i += 512) { const int b = i >> 8, n = i & 255; float s = 0.f;
#pragma unroll
            for (int w = 0; w < 8; ++w) s += part[(w * 9 + b) * 256 + n];
            adaP[(size_t)(kc * 9 + b) * 3072 + n0 + n] = s; }
        __syncthreads();
    }
    {
        float* scr = ldsf + wave * 4096;
        const int gw = bid * 8 + wave, NGW = G * 8;
        for (int it = gw; it < 1536 + 512 + 32; it += NGW) {
            if (it < 1536) { const int kb = it / 96, nb = it % 96, n0 = 32 * nb; tr_item(P.w_in, INC, 64 * kb, n0 < 2048 ? n0 : n0 + 8, WIN, 1024, n0, scr, lane); }
            else if (it < 2048) { const int r = it - 1536, kb = r / 32, nb = r % 32; tr_item(P.w_out, 1024, 64 * kb, 32 * nb, WOUT, 1024, 32 * nb, scr, lane); }
            else { const int r = it - 2048, g = r >> 3, kb = (r >> 2) & 1, nb = r & 3; tr_item(P.w_pool + (size_t)g * 128 * 128, 128, 64 * kb, 32 * nb, WP + (size_t)g * 128 * 128, 128, 32 * nb, scr, lane); }
        }
    }
    grid.sync();

    {
        float* wfs = ldsf;
        float* lfs = ldsf + 8192;
        float* AB0 = ldsf + 9216;
        float* AB1 = ldsf + 11264;
        for (int i = tid; i < 8192; i += 512) wfs[i] = P.w_in[(size_t)(i >> 3) * INC + 2048 + (i & 7)];
        if (tid < 256) { const int col = 4 * tid; f32x4 sh = *(const f32x4*)(P.b_ada + col), sc = *(const f32x4*)(P.b_ada + 1024 + col);
#pragma unroll
            for (int kc = 0; kc < 16; ++kc) { sh += *(const f32x4*)(adaP + (size_t)(kc * 9) * 3072 + col); sc += *(const f32x4*)(adaP + (size_t)(kc * 9) * 3072 + 1024 + col); }
            *(f32x4*)(AB0 + col) = *(const f32x4*)(P.norm_g + col) * (1.0f + sc); *(f32x4*)(AB0 + 1024 + col) = sh; }
        else if (bid < 9) { const int col = 4 * (tid - 256); f32x4 gt = *(const f32x4*)(P.b_ada + 2048 + col);
#pragma unroll
            for (int kc = 0; kc < 16; ++kc) gt += *(const f32x4*)(adaP + (size_t)(kc * 9 + bid) * 3072 + 2048 + col);
            *(f32x4*)(adaG + bid * 1024 + col) = gt; }
        __syncthreads();
        for (int unit_ = bid; unit_ < (NCHUNK + 256) * REP_P1; unit_ += G) { const int unit = unit_ % (NCHUNK + 256);
            if (unit < NCHUNK) {
                const int m0 = unit * 32; const bool pr = m0 < SEQ; const float* AB = AB0;
                if (!pr) { const int bi = 1 + ((m0 - SEQ) >> 6);
                    if (tid < 256) { const int col = 4 * tid; f32x4 sh = *(const f32x4*)(P.b_ada + col), sc = *(const f32x4*)(P.b_ada + 1024 + col);
#pragma unroll
                        for (int kc = 0; kc < 16; ++kc) { sh += *(const f32x4*)(adaP + (size_t)(kc * 9 + bi) * 3072 + col); sc += *(const f32x4*)(adaP + (size_t)(kc * 9 + bi) * 3072 + 1024 + col); }
                        *(f32x4*)(AB1 + col) = *(const f32x4*)(P.norm_g + col) * (1.0f + sc); *(f32x4*)(AB1 + 1024 + col) = sh; }
                    __syncthreads(); AB = AB1; }
                f32x4 xv[4][4];
#pragma unroll
                for (int r = 0; r < 4; ++r) { const int m = m0 + wave * 4 + r; const float* xrow = pr ? P.x_prompt + (size_t)m * DM : P.x_sample + (size_t)(m - SEQ) * DM;
#pragma unroll
                    for (int j = 0; j < 4; ++j) xv[r][j] = *(const f32x4*)(xrow + 4 * lane + 256 * j); }
                float lfv[4];
#pragma unroll
                for (int r = 0; r < 4; ++r) {
                    const int m = m0 + wave * 4 + r;
                    float ss = 0.f;
#pragma unroll
                    for (int j = 0; j < 4; ++j) { const f32x4 v = xv[r][j]; ss += (v[0] * v[0] + v[1] * v[1]) + (v[2] * v[2] + v[3] * v[3]); }
                    const float rs = 1.0f / sqrtf(wave_sum(ss) * (1.0f / DM) + EPS);
                    float f[8];
#pragma unroll
                    for (int e = 0; e < 8; ++e) f[e] = 0.f;
#pragma unroll
                    for (int j = 0; j < 4; ++j) { const int col = 4 * lane + 256 * j;
                        const f32x4 hv = (xv[r][j] * rs) * *(const f32x4*)(AB + col) + *(const f32x4*)(AB + 1024 + col);
                        u32x2 w; w.x = pk2(hv[0], hv[1]); w.y = pk2(hv[2], hv[3]); *(u32x2*)(XN + (size_t)m * DM + col) = w;
#pragma unroll
                        for (int i = 0; i < 4; ++i) { const f32x4 w0 = *(const f32x4*)(wfs + (col + i) * 8), w1 = *(const f32x4*)(wfs + (col + i) * 8 + 4);
                            f[0] += hv[i] * w0[0]; f[1] += hv[i] * w0[1]; f[2] += hv[i] * w0[2]; f[3] += hv[i] * w0[3]; f[4] += hv[i] * w1[0]; f[5] += hv[i] * w1[1]; f[6] += hv[i] * w1[2]; f[7] += hv[i] * w1[3]; } }
#pragma unroll
                    for (int e = 0; e < 8; ++e) f[e] = wave_sum(f[e]);
                    float fz = f[0];
#pragma unroll
                    for (int e = 1; e < 8; ++e) fz = (lane == e) ? f[e] : fz;
                    lfv[r] = fz;
                }
                if (lane < 8) { const float bfv = P.b_f[lane];
#pragma unroll
                    for (int r = 0; r < 4; ++r) { const int m = m0 + wave * 4 + r; const float z = lfv[r] + bfv; const float lf = fminf(z, 0.f) - log1pf(__expf(-fabsf(z)));
                        lfs[(wave * 4 + r) * 8 + lane] = lf;
                        if (pr) P.out[O_LFP + (size_t)m * 8 + lane] = lf; else P.out[O_LFS + (size_t)(m - SEQ) * 8 + lane] = lf; } }
                __syncthreads();
                if (tid < 8) { float a = 0.f; for (int r = 0; r < 32; ++r) { a += lfs[r * 8 + tid]; GT2[(size_t)tid * MT + m0 + r] = a * LOG2E; } TP2[unit * 8 + tid] = a * LOG2E; }
                __syncthreads();
            } else {
                const int cu = unit - NCHUNK, b = cu >> 5, s0 = (cu & 31) * 32;
                if (tid < 8) { float lv[32];
#pragma unroll
                    for (int r = 0; r < 32; ++r) lv[r] = P.cache_logf[(size_t)(b * PAST + s0 + r) * 8 + tid];
                    float a = 0.f;
#pragma unroll
                    for (int r = 0; r < 32; ++r) { a += lv[r]; GC2[(size_t)(b * 8 + tid) * PAST + s0 + r] = a * LOG2E; } TC2[cu * 8 + tid] = a * LOG2E; }
                float mx = 0.f; f32x4 ka[4], kc4[4];
#pragma unroll
                for (int r = 0; r < 4; ++r) { const float* kp = P.cache_k + (size_t)(b * PAST + s0 + wave * 4 + r) * 512 + 8 * lane; ka[r] = *(const f32x4*)kp; kc4[r] = *(const f32x4*)(kp + 4); }
#pragma unroll
                for (int r = 0; r < 4; ++r) { const f32x4 a = ka[r], c = kc4[r];
                    float s = (a[0] * a[0] + a[1] * a[1]) + (a[2] * a[2] + a[3] * a[3]) + (c[0] * c[0] + c[1] * c[1]) + (c[2] * c[2] + c[3] * c[3]);
                    s += __shfl_xor(s, 1); s += __shfl_xor(s, 2); s += __shfl_xor(s, 4); mx = fmaxf(mx, s); }
                if ((lane & 7) == 0) atomicMax(kcmax + (lane >> 3), __float_as_uint(mx));
            }
        }
    }
    xcd_barrier(bar);

    {
        pg8::Gemm g{XN, WIN, MT, NPJ, DM}; pg8::StaticOrder S; S.init(MT, NPJ, G, bid); S.rep = REP_P2;
        pg8::EpiProj E{PB, P.out, qkmax};
        static_assert(O_KP == 17301504 && O_KS == 34217472 && O_VP == 25690112 && O_VS == 34479616, "d_out map");
        pg8::gemm_phase<pg8::EpiProj, pg8::StaticOrder, true, true>((LAS unsigned char*)lds, g, S, E);
    }
    xcd_barrier(bar);

    {
        const int r32 = lane & 31, h2 = lane >> 5;
        for (int unit_ = bid; unit_ < (MT / 64) * REP_P3; unit_ += G) { const int unit = unit_ % (MT / 64);
            bf16* Ul = (bf16*)lds;
            bf16* Dl = (bf16*)(lds + 80896);
            const int r0 = unit * 64; const bool pr = r0 < SEQ; const int bb = pr ? 0 : (r0 - SEQ) >> 6;
            for (int i = tid; i < 79 * 64; i += 512) { const int rr = i >> 6, ch = i & 63, l = rr - 15; u32x4 v;
                if (l >= 0 || (pr && r0 + l >= 0)) v = *(const u32x4*)(PB + (size_t)(r0 + l) * 3072 + PB_U + 8 * ch);
                else if (pr) v = (u32x4){0u, 0u, 0u, 0u};
                else { const float* hp = P.state_pool + (size_t)(bb * 15 + 15 + l) * 512 + 8 * ch; const f32x4 a = *(const f32x4*)hp, b = *(const f32x4*)(hp + 4);
                    v.x = pk2(a[0], a[1]); v.y = pk2(a[2], a[3]); v.z = pk2(b[0], b[1]); v.w = pk2(b[2], b[3]); }
                *(u32x4*)(Ul + rr * 512 + 8 * ch) = v; }
            __syncthreads();
            {
                const int c = tid, w = 2 << (c >> 7);
                const bf16* ucol = Ul + 15 * 512 + c;
                const float invw = 1.0f / (float)w;
                float S = 0.f;
                for (int k = 1; k < w; ++k) S += bf2f(ucol[-k * 512]);
#pragma unroll 8
                for (int t = 0; t < 64; ++t) {
                    const float u = bf2f(ucol[t * 512]);
                    S += u;
                    float mean;
                    if (pr) { const int pos = r0 + t; mean = (pos + 1 < w) ? S / (float)(pos + 1) : S * invw; } else mean = S * invw;
                    Dl[t * 520 + c] = (bf16)f2bf(mean - u);
                    S -= bf2f(ucol[(t - w + 1) * 512]);
                }
                if (unit == SEQ / 64 - 1) { for (int t = 0; t < 15; ++t) P.out[O_PP + (size_t)t * 512 + c] = bf2f(ucol[(49 + t) * 512]); }
                if (!pr) { for (int t = 0; t < 15; ++t) P.out[O_PS + (size_t)(bb * 15 + t) * 512 + c] = bf2f(ucol[(49 + t) * 512]); }
            }
            __syncthreads();
            {
                const int rb = wave & 1, g = wave >> 1;
                f32x16 acc[4];
#pragma unroll
                for (int nb = 0; nb < 4; ++nb) acc[nb] = f32x16{};
#pragma unroll
                for (int ks = 0; ks < 8; ++ks) { const bf16x8 a = *(const bf16x8*)(Dl + (32 * rb + r32) * 520 + g * 128 + 16 * ks + 8 * h2);
#pragma unroll
                    for (int nb = 0; nb < 4; ++nb) { const bf16x8 bw = *(const bf16x8*)(WP + ((size_t)(g * 128 + 32 * nb + r32)) * 128 + 16 * ks + 8 * h2);
                        acc[nb] = __builtin_amdgcn_mfma_f32_32x32x16_bf16(a, bw, acc[nb], 0, 0, 0); } }
#pragma unroll
                for (int nb = 0; nb < 4; ++nb) { const int j = g * 128 + 32 * nb + r32; const float ps = P.pool_scale[j]; unsigned short pgv[16];
#pragma unroll
                    for (int r = 0; r < 16; ++r) { const int m = r0 + 32 * rb + (r & 3) + 8 * (r >> 2) + 4 * h2; pgv[r] = PB[(size_t)m * 3072 + PB_PG + j]; }
#pragma unroll
                    for (int r = 0; r < 16; ++r) { const int m = r0 + 32 * rb + (r & 3) + 8 * (r >> 2) + 4 * h2;
                        Z[(size_t)m * 1024 + 512 + j] = (bf16)f2bf(acc[nb][r] * ps * silu_f(bf2f(pgv[r]))); } }
            }
            __syncthreads();
        }
        if (bid < 64) {
            const int b = bid >> 3, hd = bid & 7, qc = wave & 1, sp = wave >> 1;
            const int q0 = SEQ + b * 64 + 32 * qc;
            const float qm2 = __uint_as_float(qkmax[2 * hd]) + __uint_as_float(qkmax[2 * hd + 1]);
            const float km2 = fmaxf(__uint_as_float(qkmax[16 + 2 * hd]) + __uint_as_float(qkmax[16 + 2 * hd + 1]), __uint_as_float(kcmax[hd]));
            const float qkb2 = 2.0f * 1.02f * SC2 * sqrtf(qm2 * km2);
            bf16x8 qr[4]; load_q(qr, PB, q0, hd, lane);
            const float gq = GT2[(size_t)hd * MT + q0 + r32];
            AttnState st; st.m = -INFINITY; st.l = 0.f; st.o0 = f32x16{}; st.o1 = f32x16{};
            float base = 0.f; int i = 1;
            if (sp == 0) attn_tile<false, true>(st, qr, gq, PB + (size_t)q0 * 3072 + PB_K + hd * 64, PB + (size_t)q0 * 3072 + PB_V + hd * 64, GT2 + (size_t)hd * MT + q0, lane);
            if (qc == 1) { base += TP2[(512 + 2 * b) * 8 + hd];
                if (sp == 1) attn_tile<false, false>(st, qr, gq + base, PB + (size_t)(q0 - 32) * 3072 + PB_K + hd * 64, PB + (size_t)(q0 - 32) * 3072 + PB_V + hd * 64, GT2 + (size_t)hd * MT + q0 - 32, lane);
                i = 2; }
            for (int c = 31; c >= 0; --c, ++i) {
                if (base + qkb2 < -THR2) break;
                base += TC2[(b * 32 + c) * 8 + hd];
                if ((i & 3) == sp) attn_tile<true, false>(st, qr, gq + base, P.cache_k + ((size_t)(b * PAST + c * 32) * 8 + hd) * 64, P.cache_v + ((size_t)(b * PAST + c * 32) * 8 + hd) * 64, GC2 + (size_t)(b * 8 + hd) * PAST + c * 32, lane);
            }
            float lt = st.l + __shfl_xor(st.l, 32);
            float* mine = ldsf + wave * (34 * 64);
            mine[lane] = st.m; mine[64 + lane] = lt;
#pragma unroll
            for (int r = 0; r < 16; ++r) { mine[(2 + r) * 64 + lane] = st.o0[r]; mine[(18 + r) * 64 + lane] = st.o1[r]; }
            __syncthreads();
            if (sp == 0) {
                float mt = st.m;
#pragma unroll
                for (int s = 1; s < 4; ++s) mt = fmaxf(mt, ldsf[(wave + 2 * s) * (34 * 64) + lane]);
                const float a0 = __builtin_amdgcn_exp2f(st.m - mt);
                lt *= a0;
#pragma unroll
                for (int r = 0; r < 16; ++r) { st.o0[r] *= a0; st.o1[r] *= a0; }
#pragma unroll
                for (int s = 1; s < 4; ++s) { const float* oth = ldsf + (wave + 2 * s) * (34 * 64); const float as = __builtin_amdgcn_exp2f(oth[lane] - mt);
                    lt += as * oth[64 + lane];
#pragma unroll
                    for (int r = 0; r < 16; ++r) { st.o0[r] += as * oth[(2 + r) * 64 + lane]; st.o1[r] += as * oth[(18 + r) * 64 + lane]; } }
                attn_finish(st, lt, PB, Z, q0, hd, lane);
            }
            __syncthreads();
        }
        for (;;) {
            unsigned u = 0; if (lane == 0) u = atomicAdd(cnt, 1u); u = __builtin_amdgcn_readfirstlane(u);
            if (u >= 4096u * REP_P3) break;
            u &= 4095u;
            const int cq = (int)(u >> 3), hd = (int)(u & 7), q0 = cq * 32;
            const float qm2 = __uint_as_float(qkmax[2 * hd]) + __uint_as_float(qkmax[2 * hd + 1]);
            const float km2 = __uint_as_float(qkmax[16 + 2 * hd]) + __uint_as_float(qkmax[16 + 2 * hd + 1]);
            const float qkb2 = 2.0f * 1.02f * SC2 * sqrtf(qm2 * km2);
            bf16x8 qr[4]; load_q(qr, PB, q0, hd, lane);
            const float gq = GT2[(size_t)hd * MT + q0 + r32];
            AttnState st; st.m = -INFINITY; st.l = 0.f; st.o0 = f32x16{}; st.o1 = f32x16{};
            attn_tile<false, true>(st, qr, gq, PB + (size_t)q0 * 3072 + PB_K + hd * 64, PB + (size_t)q0 * 3072 + PB_V + hd * 64, GT2 + (size_t)hd * MT + q0, lane);
            float base = 0.f;
            for (int ck = cq - 1; ck >= 0; --ck) {
                if (base + qkb2 < -THR2) break;
                base += TP2[ck * 8 + hd];
                attn_tile<false, false>(st, qr, gq + base, PB + (size_t)ck * 32 * 3072 + PB_K + hd * 64, PB + (size_t)ck * 32 * 3072 + PB_V + hd * 64, GT2 + (size_t)hd * MT + ck * 32, lane);
            }
            attn_finish(st, st.l + __shfl_xor(st.l, 32), PB, Z, q0, hd, lane);
        }
    }
    xcd_barrier(bar);

    {
        pg8::Gemm g{Z, WOUT, MT, DM, DM}; pg8::MergeOrder S{bid, G};
        pg8::EpiMerge E{P.x_prompt, P.x_sample, P.out + O_YP, P.out + O_YS, adaG, P.final_g, rowss, pcnt};
        pg8::gemm_phase<pg8::EpiMerge, pg8::MergeOrder, true, true>((LAS unsigned char*)lds, g, S, E);
    }
}

extern "C" void kernel_launch(void* const* d_in, const int* in_sizes, int n_in, void* d_out, int out_size, void* d_ws, size_t ws_size, hipStream_t stream) {
    static int grid = 0;
    if (grid == 0) {
        if (n_in != 17 || (size_t)out_size != O_END || ws_size < WS_END) { fprintf(stderr, "kernel_launch: unexpected problem shape (n_in %d, out %d, ws %zu)\n", n_in, out_size, ws_size); grid = -1; return; }
        int dev = 0, cus = 0, per_cu = 0;
        hipGetDevice(&dev); hipDeviceGetAttribute(&cus, hipDeviceAttributeMultiprocessorCount, dev);
        hipFuncSetAttribute((const void*)fox_pool_fwd, hipFuncAttributeMaxDynamicSharedMemorySize, LDS_BYTES);
        hipOccupancyMaxActiveBlocksPerMultiprocessor(&per_cu, (const void*)fox_pool_fwd, 512, LDS_BYTES);
        (void)hipGetLastError();
        if (per_cu < 1) { fprintf(stderr, "kernel_launch: occupancy query reports %d blocks per CU\n", per_cu); per_cu = 1; }
        grid = cus * 1;
    }
    if (grid < 0) return;
    hipMemsetAsync((char*)d_ws + WS_CTL, 0, CTL_BYTES, stream);
    Params p{};
    const float** pp = (const float**)&p;
    for (int i = 0; i < 17; ++i) pp[i] = (const float*)d_in[i];
    p.out = (float*)d_out; p.ws = (unsigned char*)d_ws;
    void* args[] = {&p};
    hipError_t e = hipLaunchCooperativeKernel((const void*)fox_pool_fwd, dim3(grid), dim3(512), args, LDS_BYTES, stream);
    if (e != hipSuccess) fprintf(stderr, "cooperative launch failed: %s (grid %d)\n", hipGetErrorString(e), grid);
}
```

```cpp
#include <hip/hip_runtime.h>
#include <hip/hip_cooperative_groups.h>
#include <cstdio>
#include <cstdint>
namespace cg = cooperative_groups;
namespace pg8 {
#define PG8_LAS __attribute__((address_space(3)))
typedef unsigned short bf16_t;
typedef short bf16x8 __attribute__((ext_vector_type(8)));
typedef float f32x4 __attribute__((ext_vector_type(4)));
typedef unsigned u32x4 __attribute__((ext_vector_type(4)));
constexpr int BM = 256, BK = 64, HALF = 128, HTB = HALF * BK * 2  , STAGE_BYTES = 8 * HTB, NXCD = 8, WGM = 8;

__host__ __device__ __forceinline__ int lds_byte(int r, int c) { const int st = (r >> 4) * 2 + (c >> 5), rr = r & 15, cc = c & 31, ob = rr * 64 + cc * 2; return st * 1024 + (ob ^ (((ob >> 9) & 1) << 5)); }
__host__ __device__ __forceinline__ void stage_rc(int b, int& R, int& C) { const int st = b / 1024, sb = b % 1024, swz = sb ^ (((sb >> 9) & 1) << 5); R = (st >> 1) * 16 + swz / 64; C = (st & 1) * 32 + (swz % 64) / 2; }
__host__ __device__ __forceinline__ int perm32(int rho) { const int n = rho >> 4, i = rho & 15; return 8 * (i >> 2) + 4 * n + (i & 3); }

struct Unit { int pm, pn; };
struct Gemm { const bf16_t* A; const bf16_t* Bt; int M, N, K; };

struct StaticOrder {
    int nM, nN, nwg, G, c, rep = 1;
    __host__ __device__ void init(int M, int N, int G_, int c_) { nM = M / BM; nN = N / BM; nwg = nM * nN; G = G_; c = c_; }
    __host__ __device__ bool next(int i, Unit& u) const {
        const long L = (long)i * G + c; if (L >= (long)nwg * rep) return false;
        int wgid = (int)(L % nwg); { const int q = nwg / NXCD, r = nwg % NXCD, xcd = wgid % NXCD, off = wgid / NXCD; wgid = (xcd < r ? xcd * (q + 1) : r * (q + 1) + (xcd - r) * q) + off; }
        const int nig = WGM * nN, gid = wgid / nig, fm = gid * WGM, gsz = (nM - fm) < WGM ? (nM - fm) : WGM;
        u.pm = fm + ((wgid % nig) % gsz); u.pn = (wgid % nig) / gsz; return true;
    }
    __device__ __forceinline__ void a_ready(const Unit&) const {}
    __device__ __forceinline__ void done(const Unit&) const {}
};

__device__ __forceinline__ unsigned cvt_pk_bf16(float lo, float hi) { unsigned r; asm volatile("v_cvt_pk_bf16_f32 %0, %1, %2" : "=v"(r) : "v"(lo), "v"(hi)); return r; }

struct EpiProj {
    static constexpr bool PERM = true, AFTER_DRAIN = false;
    bf16_t* PB; float* out; unsigned* qkmax; bf16_t* VT; PG8_LAS unsigned char* scr;
    __device__ __forceinline__ void operator()(const f32x4 (&acc)[2][2][4][2], const Unit& u, int wr, int wc, int fr, int fq) const {
        const int row0 = u.pm * BM + wr * 64 + fr; const int col0 = u.pn * BM + wc * 32 + 8 * fq;
        if (u.pn < 4 || u.pn >= 6)
#pragma unroll
        for (int ai = 0; ai < 2; ++ai)
#pragma unroll
            for (int m = 0; m < 4; ++m) { bf16_t* rowp = PB + (size_t)(row0 + ai * HALF + m * 16) * 3072 + col0;
#pragma unroll
                for (int bj = 0; bj < 2; ++bj) { const f32x4 v0 = acc[ai][bj][m][0], v1 = acc[ai][bj][m][1];
                    u32x4 w; w.x = cvt_pk_bf16(v0[0], v0[1]); w.y = cvt_pk_bf16(v0[2], v0[3]); w.z = cvt_pk_bf16(v1[0], v1[1]); w.w = cvt_pk_bf16(v1[2], v1[3]);
                    *(u32x4*)(rowp + bj * HALF) = w; } }
        if (u.pn >= 2 && u.pn < 6) {
            const size_t obase = (u.pn < 4) ? (u.pm < 64 ? (size_t)17301504 : (size_t)34217472) : (u.pm < 64 ? (size_t)25690112 : (size_t)34479616);
            float* base = out + obase;
            const int rowl = (u.pm < 64 ? u.pm : u.pm - 64) * BM + wr * 64 + fr; const int colf = (u.pn & 1) * BM + wc * 32 + 8 * fq;
#pragma unroll
            for (int ai = 0; ai < 2; ++ai)
#pragma unroll
                for (int m = 0; m < 4; ++m) { float* rp = base + (size_t)(rowl + ai * HALF + m * 16) * 512 + colf;
#pragma unroll
                    for (int bj = 0; bj < 2; ++bj) { *(f32x4*)(rp + bj * HALF) = acc[ai][bj][m][0]; *(f32x4*)(rp + bj * HALF + 4) = acc[ai][bj][m][1]; } }
        }
        if (u.pn >= 4 && u.pn < 6) {
            const int lane = fr + 16 * fq; PG8_LAS unsigned short* w = (PG8_LAS unsigned short*)(scr + (wr * 4 + wc) * 2048);
#pragma unroll
            for (int ai = 0; ai < 2; ++ai)
#pragma unroll
                for (int m = 0; m < 4; ++m) {
#pragma unroll
                    for (int bj = 0; bj < 2; ++bj) {
#pragma unroll
                        for (int n = 0; n < 2; ++n)
#pragma unroll
                            for (int e = 0; e < 4; e += 2) { const unsigned pk = cvt_pk_bf16(acc[ai][bj][m][n][e], acc[ai][bj][m][n][e + 1]); const int ci = 8 * fq + 4 * n + e;
                                w[ci * 20 + fr] = (unsigned short)(pk & 0xffffu); w[(ci + 1) * 20 + fr] = (unsigned short)(pk >> 16); }
                        asm volatile("s_waitcnt lgkmcnt(0)" ::: "memory");
                        { const int ci = lane >> 1, hf = lane & 1;
                            typedef unsigned u32x2_t __attribute__((ext_vector_type(2)));
                            const u32x2_t lo = *(const PG8_LAS u32x2_t*)(w + ci * 20 + hf * 8), hi = *(const PG8_LAS u32x2_t*)(w + ci * 20 + hf * 8 + 4);
                            const int col = (u.pn - 4) * BM + bj * HALF + wc * 32 + ci; const int row = u.pm * BM + ai * HALF + wr * 64 + m * 16 + hf * 8;
                            u32x4 o; o.x = lo.x; o.y = lo.y; o.z = hi.x; o.w = hi.y; *(u32x4*)(VT + (size_t)col * 16896 + row) = o; }
                        asm volatile("s_waitcnt lgkmcnt(0)" ::: "memory");
                    }
                }
        }
        if (u.pn < 4) {
#pragma unroll
            for (int bj = 0; bj < 2; ++bj) { float mx = 0.f;
#pragma unroll
                for (int ai = 0; ai < 2; ++ai)
#pragma unroll
                    for (int m = 0; m < 4; ++m) { const f32x4 a = acc[ai][bj][m][0], b = acc[ai][bj][m][1];
                        float s = (a[0] * a[0] + a[1] * a[1]) + (a[2] * a[2] + a[3] * a[3]) + (b[0] * b[0] + b[1] * b[1]) + (b[2] * b[2] + b[3] * b[3]);
                        s += __shfl_xor(s, 16); s += __shfl_xor(s, 32); mx = fmaxf(mx, s); }
                mx = fmaxf(mx, __shfl_xor(mx, 1)); mx = fmaxf(mx, __shfl_xor(mx, 2)); mx = fmaxf(mx, __shfl_xor(mx, 4)); mx = fmaxf(mx, __shfl_xor(mx, 8));
                if (fr == 0 && fq == 0) atomicMax(qkmax + (u.pn * 8 + bj * 4 + wc), __float_as_uint(mx)); }
        }
    }
};
struct EpiMerge {
    static constexpr bool PERM = true, AFTER_DRAIN = false;
    const float* xp; const float* xs; float* yp; float* ys; const float* gate; const float* final_g; float* rowss; unsigned* pcnt;
    __device__ __forceinline__ void operator()(f32x4 (&acc)[2][2][4][2], const Unit& u, int wr, int wc, int fr, int fq) const {
        const bool pr = u.pm < 64; const int rowl = (pr ? u.pm : u.pm - 64) * BM + wr * 64 + fr;
        const float* xb = pr ? xp : xs; float* yb = pr ? yp : ys; const int col0 = u.pn * BM + wc * 32 + 8 * fq;
#pragma unroll
        for (int ai = 0; ai < 2; ++ai) {
            const int bi = pr ? 0 : 1 + (u.pm - 64) * 4 + 2 * ai + wr;
            f32x4 gt[2][2];
#pragma unroll
            for (int bj = 0; bj < 2; ++bj)
#pragma unroll
                for (int n = 0; n < 2; ++n) gt[bj][n] = *(const f32x4*)(gate + bi * 1024 + col0 + bj * HALF + 4 * n);
#pragma unroll
            for (int mp = 0; mp < 2; ++mp) {
            f32x4 xv[2][2][2];
#pragma unroll
            for (int m2 = 0; m2 < 2; ++m2) { const size_t off = (size_t)(rowl + ai * HALF + (2 * mp + m2) * 16) * 1024 + col0;
#pragma unroll
                for (int bj = 0; bj < 2; ++bj)
#pragma unroll
                    for (int n = 0; n < 2; ++n) xv[m2][bj][n] = *(const f32x4*)(xb + off + bj * HALF + 4 * n); }
#pragma unroll
            for (int m2 = 0; m2 < 2; ++m2) { const int m = 2 * mp + m2; float ss = 0.f;
#pragma unroll
                for (int bj = 0; bj < 2; ++bj)
#pragma unroll
                    for (int n = 0; n < 2; ++n) { const f32x4 o = xv[m2][bj][n] + gt[bj][n] * acc[ai][bj][m][n]; acc[ai][bj][m][n] = o; ss += (o[0] * o[0] + o[1] * o[1]) + (o[2] * o[2] + o[3] * o[3]); }
                ss += __shfl_xor(ss, 16); ss += __shfl_xor(ss, 32);
                if (fq == 0) (void)__hip_atomic_fetch_add(rowss + u.pm * BM + ai * HALF + wr * 64 + m * 16 + fr, ss, __ATOMIC_RELAXED, __HIP_MEMORY_SCOPE_AGENT); }
            asm volatile("" ::: "memory");
            }
        }
        asm volatile("s_waitcnt vmcnt(0)" ::: "memory");
        unsigned* pc = pcnt + 64 * (u.pm * 2 + wr);
        if (fr == 0 && fq == 0) (void)__hip_atomic_fetch_add(pc, 1u, __ATOMIC_RELAXED, __HIP_MEMORY_SCOPE_AGENT);
        { unsigned sp = 0; while ((unsigned)__builtin_amdgcn_readfirstlane(__hip_atomic_load(pc, __ATOMIC_RELAXED, __HIP_MEMORY_SCOPE_AGENT)) < 16u) { __builtin_amdgcn_s_sleep(8); if (++sp > (1u << 21)) break; } }
        asm volatile("" ::: "memory");
#pragma unroll
        for (int ai = 0; ai < 2; ++ai) {
            f32x4 fg[2][2];
#pragma unroll
            for (int bj = 0; bj < 2; ++bj)
#pragma unroll
                for (int n = 0; n < 2; ++n) fg[bj][n] = *(const f32x4*)(final_g + col0 + bj * HALF + 4 * n);
            float rs[4];
#pragma unroll
            for (int m = 0; m < 4; ++m) rs[m] = __hip_atomic_load(rowss + u.pm * BM + ai * HALF + wr * 64 + m * 16 + fr, __ATOMIC_RELAXED, __HIP_MEMORY_SCOPE_AGENT);
#pragma unroll
            for (int m = 0; m < 4; ++m) { const float r = 1.0f / sqrtf(rs[m] * (1.0f / 1024.0f) + 1e-6f); const size_t off = (size_t)(rowl + ai * HALF + m * 16) * 1024 + col0;
#pragma unroll
                for (int bj = 0; bj < 2; ++bj)
#pragma unroll
                    for (int n = 0; n < 2; ++n) *(f32x4*)(yb + off + bj * HALF + 4 * n) = acc[ai][bj][m][n] * r * fg[bj][n]; }
        }
    }
};
struct OneUnit {
    int pm, pn;
    __device__ bool next(int i, Unit& u) const { if (i > 0) return false; u.pm = pm; u.pn = pn; return true; }
    __device__ __forceinline__ void a_ready(const Unit&) const {}
    __device__ __forceinline__ void done(const Unit&) const {}
};
struct MergeOrder {
    int c, G;
    __device__ bool next(int i, Unit& u) const {
        const int L = i * G + c; if (L >= 256) return false;
        if (L < 256) { const int xcd = L & 7, off = L >> 3; u.pm = xcd * 8 + (off & 7); u.pn = off >> 3; } else { u.pm = 64 + ((L - 256) >> 2); u.pn = (L - 256) & 3; }
        return true; }
    __device__ __forceinline__ void a_ready(const Unit&) const {}
    __device__ __forceinline__ void done(const Unit&) const {}
};

template <class Epi, class Sched, bool ALIGN_EPI = false, bool SP2 = false>
__device__ __forceinline__ void gemm_phase(PG8_LAS unsigned char* lds, const Gemm g, const Sched& S, const Epi& E) {
    const int tid = threadIdx.x, wid = __builtin_amdgcn_readfirstlane(tid >> 6), lane = tid & 63, wr = wid >> 2, wc = wid & 3, fr = lane & 15, fq = lane >> 4;
    const int K = g.K, nt = K / BK;
    unsigned voffA[2], voffB[2];
#pragma unroll
    for (int i = 0; i < 2; ++i) { int R, C; stage_rc(tid * 16 + i * 8192, R, C); const int Rb = Epi::PERM ? ((R & ~31) + perm32(R & 31)) : R;
        voffA[i] = (unsigned)(R * K + C) * 2u; voffB[i] = (unsigned)(Rb * K + C) * 2u; }
    const size_t kstep = (size_t)(BK * 2);
    const size_t hstep = (size_t)HALF * K * 2;
    const size_t tstep = 2 * hstep;
    const unsigned ldsw = (unsigned)wid * 1024u;
    const int aoff = lds_byte(wr * 64 + fr, fq * 8), boff = lds_byte(wc * 32 + fr, fq * 8);
#define PG8_SA(b, h) (((b) * 2 + (h)) * HTB)
#define PG8_SB(b, h) ((4 + (b) * 2 + (h)) * HTB)
#define PG8_STAGE(bufoff, gbase, voff) do { _Pragma("unroll") for (int _i = 0; _i < 2; ++_i) \
        __builtin_amdgcn_global_load_lds((const unsigned*)((const char*)(gbase) + (voff)[_i]), (PG8_LAS unsigned*)(lds + (bufoff) + ldsw + _i * 8192), 16, 0, 0); } while (0)
#define PG8_LDA(dst, b, h) do { _Pragma("unroll") for (int m = 0; m < 4; ++m) _Pragma("unroll") for (int k = 0; k < 2; ++k) dst[m][k] = *(const PG8_LAS bf16x8*)(lds + PG8_SA(b, h) + aoff + m * 2048 + k * 1024); } while (0)
#define PG8_LDB(dst, b, h) do { _Pragma("unroll") for (int n = 0; n < 2; ++n) _Pragma("unroll") for (int k = 0; k < 2; ++k) dst[n][k] = *(const PG8_LAS bf16x8*)(lds + PG8_SB(b, h) + boff + n * 2048 + k * 1024); } while (0)
#define PG8_MMA(ai, bj, At, Bt) do { __builtin_amdgcn_s_setprio(1); _Pragma("unroll") for (int m = 0; m < 4; ++m) _Pragma("unroll") for (int n = 0; n < 2; ++n) _Pragma("unroll") for (int k = 0; k < 2; ++k) \
        acc[ai][bj][m][n] = __builtin_amdgcn_mfma_f32_16x16x32_bf16(Bt[n][k], At[m][k], acc[ai][bj][m][n], 0, 0, 0); __builtin_amdgcn_s_setprio(0); } while (0)
#define PG8_WAIT_V(n) asm volatile("s_waitcnt vmcnt(" #n ")" ::: "memory")
#define PG8_WAIT_L(n) asm volatile("s_waitcnt lgkmcnt(" #n ")" ::: "memory")
#define PG8_BAR __builtin_amdgcn_s_barrier()
#define PG8_SCHED __builtin_amdgcn_sched_barrier(0)
    Unit cur, nxt; int ui = 0;
    if (!S.next(0, cur)) return;
    f32x4 acc[2][2][4][2];
#pragma unroll
    for (int a = 0; a < 2; ++a)
#pragma unroll
        for (int b = 0; b < 2; ++b)
#pragma unroll
            for (int m = 0; m < 4; ++m)
#pragma unroll
                for (int n = 0; n < 2; ++n) acc[a][b][m][n] = (f32x4){0.f, 0.f, 0.f, 0.f};
    bf16x8 At[4][2], B0[2][2], B1[2][2];
    const char* cA = (const char*)g.A + (size_t)cur.pm * tstep; const char* cB = (const char*)g.Bt + (size_t)cur.pn * tstep;
    S.a_ready(cur);
    if constexpr (SP2) {
        PG8_STAGE(PG8_SB(0, 0), cB, voffB); PG8_STAGE(PG8_SB(0, 1), cB + hstep, voffB); PG8_STAGE(PG8_SA(0, 0), cA, voffA); PG8_STAGE(PG8_SA(0, 1), cA + hstep, voffA);
        if (wr == 1) PG8_BAR;
        PG8_WAIT_V(2); PG8_BAR;
        PG8_STAGE(PG8_SB(1, 0), cB + kstep, voffB); PG8_STAGE(PG8_SA(1, 0), cA + kstep, voffA); PG8_STAGE(PG8_SB(1, 1), cB + hstep + kstep, voffB);
        PG8_WAIT_V(6); PG8_BAR;
    } else {
        PG8_STAGE(PG8_SB(0, 0), cB, voffB); PG8_STAGE(PG8_SA(0, 0), cA, voffA); PG8_STAGE(PG8_SB(0, 1), cB + hstep, voffB); PG8_STAGE(PG8_SA(0, 1), cA + hstep, voffA);
        if (wr == 1) PG8_BAR;
        PG8_WAIT_V(4); PG8_BAR;
        PG8_STAGE(PG8_SB(1, 0), cB + kstep, voffB); PG8_STAGE(PG8_SA(1, 0), cA + kstep, voffA); PG8_STAGE(PG8_SB(1, 1), cB + hstep + kstep, voffB);
        PG8_WAIT_V(6); PG8_BAR;
    }
    for (;;) {
        const bool has_next = S.next(ui + 1, nxt);
        const char* nA = has_next ? (const char*)g.A + (size_t)nxt.pm * tstep : cA; const char* nB = has_next ? (const char*)g.Bt + (size_t)nxt.pn * tstep : cB;
        for (int t = 0; t < nt; t += 2) {
            const bool last = (t == nt - 2);
            const char* a1 = cA + (size_t)(t + 1) * kstep;
            const char* a2 = last ? nA : cA + (size_t)(t + 2) * kstep; const char* b2 = last ? nB : cB + (size_t)(t + 2) * kstep;
            const char* a3 = a2 + kstep; const char* b3 = b2 + kstep;
            if (last && has_next) S.a_ready(nxt);
            if constexpr (SP2) {
            PG8_LDB(B0, 0, 0); PG8_LDB(B1, 0, 1); PG8_SCHED; PG8_LDA(At, 0, 0); PG8_STAGE(PG8_SA(1, 1), a1 + hstep, voffA);
            PG8_WAIT_V(8); PG8_WAIT_L(0); PG8_BAR; PG8_MMA(0, 0, At, B0); PG8_MMA(0, 1, At, B1); PG8_BAR; PG8_SCHED;
            PG8_LDA(At, 0, 1); PG8_STAGE(PG8_SB(0, 0), b2, voffB); PG8_STAGE(PG8_SB(0, 1), b2 + hstep, voffB); PG8_STAGE(PG8_SA(0, 0), a2, voffA);
            PG8_WAIT_V(8); PG8_WAIT_L(0); PG8_BAR; PG8_MMA(1, 0, At, B0); PG8_MMA(1, 1, At, B1); PG8_BAR; PG8_SCHED;
            PG8_LDB(B0, 1, 0); PG8_LDB(B1, 1, 1); PG8_SCHED; PG8_LDA(At, 1, 0); PG8_STAGE(PG8_SA(0, 1), a2 + hstep, voffA);
            PG8_WAIT_V(8); PG8_WAIT_L(0); PG8_BAR; PG8_MMA(0, 0, At, B0); PG8_MMA(0, 1, At, B1); PG8_BAR; PG8_SCHED;
            PG8_LDA(At, 1, 1); PG8_STAGE(PG8_SB(1, 0), b3, voffB); PG8_STAGE(PG8_SB(1, 1), b3 + hstep, voffB); PG8_STAGE(PG8_SA(1, 0), a3, voffA);
            PG8_WAIT_V(8); PG8_WAIT_L(0); PG8_BAR; PG8_MMA(1, 0, At, B0); PG8_MMA(1, 1, At, B1); PG8_BAR; PG8_SCHED;
            } else {
            PG8_LDB(B0, 0, 0); PG8_SCHED; PG8_LDA(At, 0, 0); PG8_STAGE(PG8_SA(1, 1), a1 + hstep, voffA);
            PG8_WAIT_L(8); PG8_BAR; PG8_WAIT_L(0); PG8_MMA(0, 0, At, B0); PG8_BAR; PG8_SCHED;
            PG8_LDB(B1, 0, 1); PG8_STAGE(PG8_SB(0, 0), b2, voffB);
            PG8_BAR; PG8_WAIT_L(0); PG8_MMA(0, 1, At, B1); PG8_BAR;
            PG8_LDA(At, 0, 1); PG8_STAGE(PG8_SA(0, 0), a2, voffA);
            PG8_BAR; PG8_WAIT_L(0); PG8_MMA(1, 0, At, B0); PG8_BAR; PG8_SCHED;
            PG8_STAGE(PG8_SB(0, 1), b2 + hstep, voffB);
            PG8_WAIT_V(6); PG8_BAR; PG8_MMA(1, 1, At, B1); PG8_BAR;
            PG8_LDB(B0, 1, 0); PG8_SCHED; PG8_LDA(At, 1, 0); PG8_STAGE(PG8_SA(0, 1), a2 + hstep, voffA);
            PG8_WAIT_L(8); PG8_BAR; PG8_WAIT_L(0); PG8_MMA(0, 0, At, B0); PG8_BAR; PG8_SCHED;
            PG8_LDB(B1, 1, 1); PG8_STAGE(PG8_SB(1, 0), b3, voffB);
            PG8_BAR; PG8_WAIT_L(0); PG8_MMA(0, 1, At, B1); PG8_BAR;
            PG8_LDA(At, 1, 1); PG8_STAGE(PG8_SA(1, 0), a3, voffA);
            PG8_BAR; PG8_WAIT_L(0); PG8_MMA(1, 0, At, B0); PG8_BAR; PG8_SCHED;
            PG8_STAGE(PG8_SB(1, 1), b3 + hstep, voffB);
            PG8_WAIT_V(6); PG8_BAR; PG8_MMA(1, 1, At, B1); PG8_BAR;
            }
        }
        if constexpr (ALIGN_EPI) { if (wr == 0) PG8_BAR; }
        if constexpr (!Epi::AFTER_DRAIN) { E(acc, cur, wr, wc, fr, fq); S.done(cur); }
        if (!has_next) break;
#pragma unroll
        for (int a = 0; a < 2; ++a)
#pragma unroll
            for (int b = 0; b < 2; ++b)
#pragma unroll
                for (int m = 0; m < 4; ++m)
#pragma unroll
                    for (int n = 0; n < 2; ++n) acc[a][b][m][n] = (f32x4){0.f, 0.f, 0.f, 0.f};
        cur = nxt; cA = nA; cB = nB; ++ui;
        if constexpr (ALIGN_EPI) { if (wr == 1) PG8_BAR; }
    }
    PG8_WAIT_V(0);
    if constexpr (!ALIGN_EPI) { if (wr == 0) PG8_BAR; }
    PG8_BAR;
    if constexpr (Epi::AFTER_DRAIN) { E.fused(acc, cur, wr, wc, fr, fq, lds, wid, lane); S.done(cur); }
#undef PG8_SA
#undef PG8_SB
#undef PG8_STAGE
#undef PG8_LDA
#undef PG8_LDB
#undef PG8_MMA
#undef PG8_WAIT_V
#undef PG8_WAIT_L
#undef PG8_BAR
#undef PG8_SCHED
}
}

#ifndef REP_P0
#define REP_P0 1
#endif
#ifndef REP_P1
#define REP_P1 1
#endif
#ifndef REP_P2
#define REP_P2 1
#endif
#ifndef REP_P3
#define REP_P3 1
#endif
#ifndef REP_POOL
#define REP_POOL REP_P3
#endif
#ifndef REP_PA
#define REP_PA REP_P3
#endif
#ifndef REP_SA
#define REP_SA 1
#endif
#ifndef TPROBE
#define TPROBE 0
#endif
#ifndef REP_P4
#define REP_P4 1
#endif
#ifndef XSYNC
#define XSYNC 0
#endif
typedef unsigned short bf16;
typedef short bf16x8 __attribute__((ext_vector_type(8)));
typedef float f32x4 __attribute__((ext_vector_type(4)));
typedef float f32x16 __attribute__((ext_vector_type(16)));
typedef unsigned u32x4 __attribute__((ext_vector_type(4)));
typedef unsigned u32x2 __attribute__((ext_vector_type(2)));
#define LAS __attribute__((address_space(3)))
constexpr int DM = 1024, SEQ = 16384, NSAMP = 512, MT = SEQ + NSAMP, INC = 3080, NPJ = 3072, PAST = 1024;
constexpr int NCHUNK = MT / 32;
constexpr float EPS = 1e-6f, LOG2E = 1.4426950408889634f;
constexpr float SC2 = 0.125f * LOG2E;
constexpr float THR2 = 40.0f * LOG2E;
constexpr size_t MiB = 1u << 20;
constexpr size_t WS_CTL = 0, CTL_BYTES = 1 * MiB;
constexpr size_t WS_WIN = 2 * MiB, WS_WOUT = 8 * MiB, WS_WP = 10 * MiB, WS_GT = 11 * MiB, WS_TP = 12 * MiB, WS_GC = 12 * MiB + 65536, WS_TC = 12 * MiB + 524288;
constexpr size_t WS_ADAP = 13 * MiB  , WS_ADAG = 15 * MiB  ;
constexpr size_t WS_XN = 16 * MiB, WS_PB = 50 * MiB, WS_Z = 150 * MiB, WS_VT = 184 * MiB  , WS_END = 202 * MiB;
constexpr int CW_ROWSS = 32768, CW_QKMAX = 49920, CW_KCMAX = 49984, CW_CNT = 50048, CW_PCNT = 51200  , CW_SIGA = 60032  , CW_SIGB = 60096  , CW_BAR = 65536  ;
constexpr int PB_Q = 0, PB_K = 512, PB_V = 1024, PB_AG = 1536, PB_U = 2048, PB_PG = 2560;
constexpr int LDS_BYTES = 148480, MISC_OFF = 147456;

struct Params {
    const float *x_prompt, *x_sample, *c_prompt, *c_sample, *cache_k, *cache_v, *cache_logf, *state_pool, *norm_g, *w_ada, *b_ada, *w_in, *b_f, *w_pool, *pool_scale, *w_out, *final_g;
    float* out; unsigned char* ws;
};
constexpr size_t O_YP = 0, O_YS = O_YP + (size_t)SEQ * DM, O_KP = O_YS + (size_t)NSAMP * DM, O_VP = O_KP + (size_t)SEQ * 512, O_LFP = O_VP + (size_t)SEQ * 512,
                 O_PP = O_LFP + (size_t)SEQ * 8, O_KS = O_PP + 15 * 512, O_VS = O_KS + (size_t)NSAMP * 512, O_LFS = O_VS + (size_t)NSAMP * 512, O_PS = O_LFS + (size_t)NSAMP * 8, O_END = O_PS + 8 * 15 * 512;

__device__ __forceinline__ unsigned f2bf(float f) { unsigned u = __builtin_bit_cast(unsigned, f); return (u + 0x7fffu + ((u >> 16) & 1u)) >> 16; }
__device__ __forceinline__ unsigned cvtpk(float lo, float hi) { typedef float f2 __attribute__((ext_vector_type(2))); typedef __bf16 b2 __attribute__((ext_vector_type(2))); f2 v = {lo, hi}; b2 b = __builtin_convertvector(v, b2); return __builtin_bit_cast(unsigned, b); }
__device__ __forceinline__ unsigned pk2(float lo, float hi) { return cvtpk(lo, hi); }
__device__ __forceinline__ float bf2f(unsigned short b) { return __uint_as_float(((unsigned)b) << 16); }
__device__ __forceinline__ float wave_sum(float v) {
#pragma unroll
    for (int o = 1; o < 64; o <<= 1) v += __shfl_xor(v, o);
    return v;
}
__device__ __forceinline__ float silu_f(float v) { return v * __builtin_amdgcn_rcpf(1.0f + __expf(-v)); }

__device__ __forceinline__ void tr_item(const float* W, int ldw, int k0, int c0, bf16* WT, int ldt, int n0, float* scr, int lane) {
#pragma unroll 8
    for (int i = 0; i < 32; ++i) { const int kk = 2 * i + (lane >> 5); scr[kk * 33 + (lane & 31)] = W[(size_t)(k0 + kk) * ldw + c0 + (lane & 31)]; }
    asm volatile("s_waitcnt lgkmcnt(0)" ::: "memory");
    const int c = lane & 7;
#pragma unroll
    for (int j = 0; j < 4; ++j) { const int n = (lane >> 3) + 8 * j; const float* s = scr + (8 * c) * 33 + n;
        u32x4 o; o.x = pk2(s[0 * 33], s[1 * 33]); o.y = pk2(s[2 * 33], s[3 * 33]); o.z = pk2(s[4 * 33], s[5 * 33]); o.w = pk2(s[6 * 33], s[7 * 33]);
        *(u32x4*)(WT + (size_t)(n0 + n) * ldt + k0 + 8 * c) = o; }
    asm volatile("s_waitcnt lgkmcnt(0)" ::: "memory");
}

struct AttnState { float m, l; f32x16 o0, o1; };

template <bool F32SRC, bool DIAG>
__device__ __forceinline__ void attn_tile(AttnState& st, const bf16x8 (&qr)[4], float gqb, const void* kb, const void* vb, const float* g2, int lane) {
    int r32 = lane & 31, h2 = lane >> 5;
    asm volatile("" : "+v"(r32), "+v"(h2));
    bf16x8 kf[4]; bf16x8 va[2][2]; f32x4 gk[4];
    if constexpr (!F32SRC) {
        const bf16* kp = (const bf16*)kb + (size_t)r32 * 3072 + 8 * h2;
#pragma unroll
        for (int d0 = 0; d0 < 4; ++d0) kf[d0] = *(const bf16x8*)(kp + 16 * d0);
#pragma unroll
        for (int i = 0; i < 4; ++i) gk[i] = *(const f32x4*)(g2 + 8 * i + 4 * h2);
        const bf16* vp = (const bf16*)vb + (size_t)r32 * MT + 4 * h2;
        u32x2 vr[2][2][2];
#pragma unroll
        for (int db = 0; db < 2; ++db)
#pragma unroll
            for (int s = 0; s < 2; ++s)
#pragma unroll
                for (int g = 0; g < 2; ++g) vr[db][s][g] = *(const u32x2*)(vp + (size_t)(32 * db) * MT + 16 * s + 8 * g);
        asm volatile("" ::: "memory");
#pragma unroll
        for (int db = 0; db < 2; ++db)
#pragma unroll
            for (int s = 0; s < 2; ++s) { u32x4 w; w.x = vr[db][s][0].x; w.y = vr[db][s][0].y; w.z = vr[db][s][1].x; w.w = vr[db][s][1].y; va[db][s] = __builtin_bit_cast(bf16x8, w); }
    } else {
        const float* kp = (const float*)kb + (size_t)r32 * 512 + 8 * h2;
        f32x4 kr[4][2];
#pragma unroll
        for (int d0 = 0; d0 < 4; ++d0) { kr[d0][0] = *(const f32x4*)(kp + 16 * d0); kr[d0][1] = *(const f32x4*)(kp + 16 * d0 + 4); }
#pragma unroll
        for (int i = 0; i < 4; ++i) gk[i] = *(const f32x4*)(g2 + 8 * i + 4 * h2);
        const float* vp = (const float*)vb + r32 + (size_t)(4 * h2) * 512;
        float vr[2][2][8];
#pragma unroll
        for (int db = 0; db < 2; ++db)
#pragma unroll
            for (int s = 0; s < 2; ++s)
#pragma unroll
                for (int j = 0; j < 8; ++j) vr[db][s][j] = vp[(size_t)(16 * s + 8 * (j >> 2) + (j & 3)) * 512 + 32 * db];
        asm volatile("" ::: "memory");
#pragma unroll
        for (int d0 = 0; d0 < 4; ++d0) { const f32x4 a = kr[d0][0], b = kr[d0][1];
            u32x4 w; w.x = cvtpk(a[0], a[1]); w.y = cvtpk(a[2], a[3]); w.z = cvtpk(b[0], b[1]); w.w = cvtpk(b[2], b[3]); kf[d0] = __builtin_bit_cast(bf16x8, w); }
#pragma unroll
        for (int db = 0; db < 2; ++db)
#pragma unroll
            for (int s = 0; s < 2; ++s) { u32x4 w;
#pragma unroll
                for (int jj = 0; jj < 4; ++jj) w[jj] = cvtpk(vr[db][s][2 * jj], vr[db][s][2 * jj + 1]);
                va[db][s] = __builtin_bit_cast(bf16x8, w); }
    }
    f32x16 S = {};
#pragma unroll
    for (int d0 = 0; d0 < 4; ++d0) S = __builtin_amdgcn_mfma_f32_32x32x16_bf16(kf[d0], qr[d0], S, 0, 0, 0);
    float mx = -INFINITY;
#pragma unroll
    for (int r = 0; r < 16; ++r) { float v = S[r] * SC2 + (gqb - gk[r >> 2][r & 3]);
        if (DIAG) { const int kvl = (r & 3) + 8 * (r >> 2) + 4 * h2; if (kvl > r32) v = -INFINITY; }
        S[r] = v; mx = fmaxf(mx, v); }
    mx = fmaxf(mx, __shfl_xor(mx, 32));
    const float mn = fmaxf(st.m, mx); const float alpha = __builtin_amdgcn_exp2f(st.m - mn); st.m = mn;
    float sum = 0.f;
#pragma unroll
    for (int r = 0; r < 16; ++r) { S[r] = __builtin_amdgcn_exp2f(S[r] - mn); sum += S[r]; }
    st.l = st.l * alpha + sum;
#pragma unroll
    for (int r = 0; r < 16; ++r) { st.o0[r] *= alpha; st.o1[r] *= alpha; }
    bf16x8 pb[2];
#pragma unroll
    for (int s = 0; s < 2; ++s) { u32x4 w; w.x = cvtpk(S[8 * s + 0], S[8 * s + 1]); w.y = cvtpk(S[8 * s + 2], S[8 * s + 3]); w.z = cvtpk(S[8 * s + 4], S[8 * s + 5]); w.w = cvtpk(S[8 * s + 6], S[8 * s + 7]); pb[s] = __builtin_bit_cast(bf16x8, w); }
    st.o0 = __builtin_amdgcn_mfma_f32_32x32x16_bf16(va[0][0], pb[0], st.o0, 0, 0, 0); st.o0 = __builtin_amdgcn_mfma_f32_32x32x16_bf16(va[0][1], pb[1], st.o0, 0, 0, 0);
    st.o1 = __builtin_amdgcn_mfma_f32_32x32x16_bf16(va[1][0], pb[0], st.o1, 0, 0, 0); st.o1 = __builtin_amdgcn_mfma_f32_32x32x16_bf16(va[1][1], pb[1], st.o1, 0, 0, 0);
}
struct TileRegs { bf16x8 kf[4]; u32x2 vr[2][2][2]; f32x4 gk[4]; };
__device__ __forceinline__ void tile_load(TileRegs& T, const bf16* kb, const bf16* vb, const float* g2, int lane) {
    int r32 = lane & 31, h2 = lane >> 5;
    asm volatile("" : "+v"(r32), "+v"(h2));
    const bf16* kp = kb + (size_t)r32 * 3072 + 8 * h2;
#pragma unroll
    for (int d0 = 0; d0 < 4; ++d0) T.kf[d0] = *(const bf16x8*)(kp + 16 * d0);
#pragma unroll
    for (int i = 0; i < 4; ++i) T.gk[i] = *(const f32x4*)(g2 + 8 * i + 4 * h2);
    const bf16* vp = vb + (size_t)r32 * MT + 4 * h2;
#pragma unroll
    for (int db = 0; db < 2; ++db)
#pragma unroll
        for (int s = 0; s < 2; ++s)
#pragma unroll
            for (int g = 0; g < 2; ++g) T.vr[db][s][g] = *(const u32x2*)(vp + (size_t)(32 * db) * MT + 16 * s + 8 * g);
}
template <bool DIAG>
__device__ __forceinline__ void tile_compute(AttnState& st, const bf16x8* qls, float gqb, const TileRegs& T, int lane) {
    const int r32 = lane & 31, h2 = lane >> 5;
    bf16x8 qr[4];
#pragma unroll
    for (int d0 = 0; d0 < 4; ++d0) qr[d0] = qls[d0 * 64 + lane];
    f32x16 S = {};
#pragma unroll
    for (int d0 = 0; d0 < 4; ++d0) S = __builtin_amdgcn_mfma_f32_32x32x16_bf16(T.kf[d0], qr[d0], S, 0, 0, 0);
    float mx = -INFINITY;
#pragma unroll
    for (int r = 0; r < 16; ++r) { float v = S[r] * SC2 + (gqb - T.gk[r >> 2][r & 3]);
        if (DIAG) { const int kvl = (r & 3) + 8 * (r >> 2) + 4 * h2; if (kvl > r32) v = -INFINITY; }
        S[r] = v; mx = fmaxf(mx, v); }
    mx = fmaxf(mx, __shfl_xor(mx, 32));
    const float mn = fmaxf(st.m, mx); const float alpha = __builtin_amdgcn_exp2f(st.m - mn); st.m = mn;
    float sum = 0.f;
#pragma unroll
    for (int r = 0; r < 16; ++r) { S[r] = __builtin_amdgcn_exp2f(S[r] - mn); sum += S[r]; }
    st.l = st.l * alpha + sum;
#pragma unroll
    for (int r = 0; r < 16; ++r) { st.o0[r] *= alpha; st.o1[r] *= alpha; }
    bf16x8 pb[2];
#pragma unroll
    for (int s = 0; s < 2; ++s) { u32x4 w; w.x = cvtpk(S[8 * s + 0], S[8 * s + 1]); w.y = cvtpk(S[8 * s + 2], S[8 * s + 3]); w.z = cvtpk(S[8 * s + 4], S[8 * s + 5]); w.w = cvtpk(S[8 * s + 6], S[8 * s + 7]); pb[s] = __builtin_bit_cast(bf16x8, w); }
    bf16x8 va[2][2];
#pragma unroll
    for (int db = 0; db < 2; ++db)
#pragma unroll
        for (int s = 0; s < 2; ++s) { u32x4 w; w.x = T.vr[db][s][0].x; w.y = T.vr[db][s][0].y; w.z = T.vr[db][s][1].x; w.w = T.vr[db][s][1].y; va[db][s] = __builtin_bit_cast(bf16x8, w); }
    st.o0 = __builtin_amdgcn_mfma_f32_32x32x16_bf16(va[0][0], pb[0], st.o0, 0, 0, 0); st.o0 = __builtin_amdgcn_mfma_f32_32x32x16_bf16(va[0][1], pb[1], st.o0, 0, 0, 0);
    st.o1 = __builtin_amdgcn_mfma_f32_32x32x16_bf16(va[1][0], pb[0], st.o1, 0, 0, 0); st.o1 = __builtin_amdgcn_mfma_f32_32x32x16_bf16(va[1][1], pb[1], st.o1, 0, 0, 0);
}
__device__ __forceinline__ void attn_finish(const AttnState& st, float ltot, const bf16* PB, bf16* Z, int q0, int hd, int lane) {
    const int r32 = lane & 31, h2 = lane >> 5; const float inv = 1.0f / ltot;
    const bf16* agp = PB + (size_t)(q0 + r32) * 3072 + PB_AG + hd * 64 + 4 * h2; bf16* zp = Z + (size_t)(q0 + r32) * 1024 + hd * 64 + 4 * h2;
    u32x2 av[2][4];
#pragma unroll
    for (int db = 0; db < 2; ++db)
#pragma unroll
        for (int i = 0; i < 4; ++i) av[db][i] = *(const u32x2*)(agp + 32 * db + 8 * i);
#pragma unroll
    for (int db = 0; db < 2; ++db)
#pragma unroll
        for (int i = 0; i < 4; ++i) { const u32x2 a = av[db][i];
            const float a0 = __uint_as_float(a.x << 16), a1 = __uint_as_float(a.x & 0xffff0000u), a2 = __uint_as_float(a.y << 16), a3 = __uint_as_float(a.y & 0xffff0000u);
            const f32x16& o = db ? st.o1 : st.o0;
            u32x2 w; w.x = cvtpk(o[4 * i + 0] * inv * silu_f(a0), o[4 * i + 1] * inv * silu_f(a1)); w.y = cvtpk(o[4 * i + 2] * inv * silu_f(a2), o[4 * i + 3] * inv * silu_f(a3));
            *(u32x2*)(zp + 32 * db + 8 * i) = w; }
}
__device__ __forceinline__ void load_q(bf16x8 (&qr)[4], const bf16* PB, int q0, int hd, int lane) {
    const bf16* qp = PB + (size_t)(q0 + (lane & 31)) * 3072 + PB_Q + hd * 64 + 8 * (lane >> 5);
#pragma unroll
    for (int d0 = 0; d0 < 4; ++d0) qr[d0] = *(const bf16x8*)(qp + 16 * d0);
}

#define GAS __attribute__((address_space(1)))
#define RLX_AGENT __ATOMIC_RELAXED, __HIP_MEMORY_SCOPE_AGENT
#define XB_TMO      128
#define XB_XCNT(j)  (256  + 64 * (j))
#define XB_XSUB(j)  (1280 + 64 * (j))
#define XB_XGEN(j)  (2304 + 64 * (j))
#define XB_TOP      3328
#define XB_TOPGEN   3392
#define XCD_BAR_WORDS 3456
#define XB_SPIN_CAP (1u << 18)

__device__ __forceinline__ unsigned xb_ld(unsigned* p)              { return __hip_atomic_load(p, __ATOMIC_RELAXED, __HIP_MEMORY_SCOPE_AGENT); }
__device__ __forceinline__ unsigned xb_add(unsigned* p, unsigned v) { return __hip_atomic_fetch_add(p, v, __ATOMIC_RELAXED, __HIP_MEMORY_SCOPE_AGENT); }
__device__ __forceinline__ unsigned xb_xcc_id() { return (unsigned)__builtin_amdgcn_s_getreg((3 << 11) | 20) & 0xFu; }
#define XB_SPIN(cond, bar) do { unsigned _sp = 0; while (cond) { __builtin_amdgcn_s_sleep(1); \
    if ((++_sp & 255u) == 0u) { if (xb_ld(&(bar)[XB_TMO])) break; if (_sp > XB_SPIN_CAP) { atomicAdd(&(bar)[XB_TMO], 1u); break; } } } } while (0)

struct XcdBarrier {
    unsigned* bar; unsigned x;
    volatile LAS unsigned* st;
};

__device__ __forceinline__ XcdBarrier xcd_barrier_post(unsigned* bar, volatile LAS unsigned* st) {
    XcdBarrier b; b.bar = bar; b.x = xb_xcc_id(); b.st = st;
    if (threadIdx.x == 0) (void)xb_add(&bar[XB_XCNT(b.x)], 1u);
    return b;
}
__device__ __forceinline__ void xcd_barrier_complete(unsigned* bar, unsigned x, unsigned& nloc, unsigned& nx) {
    const unsigned G = gridDim.x * gridDim.y * gridDim.z;
    unsigned sum, cnt, mine, sp = 0u;
    for (;;) {
        sum = 0u; cnt = 0u; mine = 0u;
#pragma unroll
        for (unsigned j = 0; j < 16; ++j) { const unsigned c = xb_ld(&bar[XB_XCNT(j)]); sum += c; cnt += (c > 0u) ? 1u : 0u; mine = (j == x) ? c : mine; }
        if (sum == G) break;
        __builtin_amdgcn_s_sleep(1);
        if ((++sp & 255u) == 0u) { if (xb_ld(&bar[XB_TMO])) break; if (sp > XB_SPIN_CAP) { atomicAdd(&bar[XB_TMO], 1u); break; } }
    }
    nloc = mine > 0u ? mine : 1u; nx = cnt > 0u ? cnt : 1u;
}

__device__ __forceinline__ void xcd_barrier(const XcdBarrier& b) {
    asm volatile("s_waitcnt vmcnt(0)" ::: "memory");
    __syncthreads();
    if (threadIdx.x == 0) {
        unsigned* bar = b.bar;
        __builtin_amdgcn_s_waitcnt(0);
        unsigned nloc = b.st[0], nx = b.st[1];
        if (nloc == 0u) { xcd_barrier_complete(bar, b.x, nloc, nx); b.st[0] = nloc; b.st[1] = nx; }
        const unsigned old = xb_add(&bar[XB_XSUB(b.x)], 1u);
        const unsigned gen = old / nloc;
        if (old + 1u == (gen + 1u) * nloc) {
            __builtin_amdgcn_fence(__ATOMIC_RELEASE, "agent");
            asm volatile("s_waitcnt vmcnt(0)" ::: "memory");
            const unsigned og = xb_add(&bar[XB_TOP], 1u);
            const unsigned tg = og / nx;
            if (og + 1u == (tg + 1u) * nx) xb_add(&bar[XB_TOPGEN], 1u);
            else XB_SPIN(xb_ld(&bar[XB_TOPGEN]) == tg, bar);
            __builtin_amdgcn_fence(__ATOMIC_ACQUIRE, "agent");
            xb_add(&bar[XB_XGEN(b.x)], 1u);
            asm volatile("s_waitcnt vmcnt(0)" ::: "memory");
        } else {
            XB_SPIN(xb_ld(&bar[XB_XGEN(b.x)]) == gen, bar);
            __builtin_amdgcn_fence(__ATOMIC_ACQUIRE, "agent");
            asm volatile("s_waitcnt vmcnt(0)" ::: "memory");
        }
    }
    __syncthreads();
}

__global__ void __launch_bounds__(512, 2) fox_pool_fwd(Params P) {
    extern __shared__ __attribute__((aligned(16))) unsigned char lds[];
    const int tid = threadIdx.x, lane = tid & 63, wave = __builtin_amdgcn_readfirstlane(tid >> 6), G = gridDim.x, bid = blockIdx.x;
    unsigned char* ws = P.ws;
    float* ctlf = (float*)(ws + WS_CTL); unsigned* ctlu = (unsigned*)(ws + WS_CTL);
    float* adaP = (float*)(ws + WS_ADAP); float* adaG = (float*)(ws + WS_ADAG); float* rowss = ctlf + CW_ROWSS; unsigned* pcnt = ctlu + CW_PCNT; unsigned* qkmax = ctlu + CW_QKMAX; unsigned* kcmax = ctlu + CW_KCMAX; unsigned* cnt = ctlu + CW_CNT;
    bf16* WIN = (bf16*)(ws + WS_WIN); bf16* WOUT = (bf16*)(ws + WS_WOUT); bf16* WP = (bf16*)(ws + WS_WP);
    float* GT2 = (float*)(ws + WS_GT); float* TP2 = (float*)(ws + WS_TP); float* GC2 = (float*)(ws + WS_GC); float* TC2 = (float*)(ws + WS_TC);
    bf16* XN = (bf16*)(ws + WS_XN); bf16* PB = (bf16*)(ws + WS_PB); bf16* Z = (bf16*)(ws + WS_Z); bf16* VT = (bf16*)(ws + WS_VT);
    float* ldsf = (float*)lds;
    volatile LAS unsigned* MISC = (volatile LAS unsigned*)((LAS unsigned char*)lds + MISC_OFF);
    if (tid < 16) MISC[tid] = 0u;
    __syncthreads();
    const XcdBarrier bar = xcd_barrier_post(ctlu + CW_BAR, MISC);
    unsigned long long tp0 = 0, tp1 = 0; if (TPROBE) tp0 = __builtin_amdgcn_s_memrealtime();
#define TP(k) do { if (TPROBE == (k)) tp1 = __builtin_amdgcn_s_memrealtime(); } while (0)

    for (int task_ = bid; task_ < 192 * REP_P0; task_ += G) { const int task = task_ % 192;
        const int cb = task % 12, kc = task / 12, k0 = kc * 64, n0 = cb * 256;
        float* Ssh = ldsf; float* part = ldsf + 1024;
        for (int i = tid; i < 576; i += 512) { const int b = i >> 6, kk = i & 63; const float c = (b == 0) ? P.c_prompt[k0 + kk] : P.c_sample[(b - 1) * 1024 + k0 + kk]; Ssh[i] = silu_f(c); }
        __syncthreads();
        f32x4 acc[9];
#pragma unroll
        for (int b = 0; b < 9; ++b) acc[b] = (f32x4){0.f, 0.f, 0.f, 0.f};
#pragma unroll
        for (int r = 0; r < 8; ++r) { const int k = wave * 8 + r; const f32x4 w = *(const f32x4*)(P.w_ada + (size_t)(k0 + k) * 3072 + n0 + 4 * lane);
#pragma unroll
            for (int b = 0; b < 9; ++b) acc[b] += Ssh[b * 64 + k] * w; }
#pragma unroll
        for (int b = 0; b < 9; ++b) *(f32x4*)(part + (wave * 9 + b) * 256 + 4 * lane) = acc[b];
        __syncthreads();
        for (int i = tid; i < 2304; i += 512) { const int b = i >> 8, n = i & 255; float s = 0.f;
#pragma unroll
            for (int w = 0; w < 8; ++w) s += part[(w * 9 + b) * 256 + n];
            adaP[(size_t)(kc * 9 + b) * 3072 + n0 + n] = s; }
        __syncthreads();
    }
    xcd_barrier(bar);
    TP(1);

    {
        float* wfs = ldsf;
        float* lfs = ldsf + 8192;
        float* AB0 = ldsf + 9216;
        float* AB1 = ldsf + 11264;
        { float wv[16];
#pragma unroll
            for (int q = 0; q < 16; ++q) { const int i = tid + 512 * q, k = i >> 3, e = i & 7; wv[q] = P.w_in[(size_t)k * INC + 2048 + e]; }
#pragma unroll
            for (int q = 0; q < 16; ++q) { const int i = tid + 512 * q, k = i >> 3, e = i & 7; wfs[((((k >> 8) * 4 + (k & 3)) * 2 + (e >> 2)) * 64 + ((k >> 2) & 63)) * 4 + (e & 3)] = wv[q]; } }
        if (tid < 256) { const int col = 4 * tid; f32x4 sh = *(const f32x4*)(P.b_ada + col), sc = *(const f32x4*)(P.b_ada + 1024 + col);
#pragma unroll
            for (int kc = 0; kc < 16; ++kc) { sh += *(const f32x4*)(adaP + (size_t)(kc * 9) * 3072 + col); sc += *(const f32x4*)(adaP + (size_t)(kc * 9) * 3072 + 1024 + col); }
            *(f32x4*)(AB0 + col) = *(const f32x4*)(P.norm_g + col) * (1.0f + sc); *(f32x4*)(AB0 + 1024 + col) = sh; }
        else if (bid < 9) { const int col = 4 * (tid - 256); f32x4 gt = *(const f32x4*)(P.b_ada + 2048 + col);
#pragma unroll
            for (int kc = 0; kc < 16; ++kc) gt += *(const f32x4*)(adaP + (size_t)(kc * 9 + bid) * 3072 + 2048 + col);
            *(f32x4*)(adaG + bid * 1024 + col) = gt; }
        __syncthreads();
        for (int kk = 0; kk < 4; ++kk) {
            const int unit = kk < 3 ? bid + 256 * kk : ((bid >= 16 && bid < 32) ? 752 + bid : -1);
            if (unit < 0 || unit >= NCHUNK + 256) continue;
            if (unit < NCHUNK) {
                const int m0 = unit * 32; const bool pr = m0 < SEQ; const float* AB = AB0;
                if (!pr) { const int bi = 1 + ((m0 - SEQ) >> 6);
                    if (tid < 256) { const int col = 4 * tid; f32x4 sh = *(const f32x4*)(P.b_ada + col), sc = *(const f32x4*)(P.b_ada + 1024 + col);
#pragma unroll
                        for (int kc = 0; kc < 16; ++kc) { sh += *(const f32x4*)(adaP + (size_t)(kc * 9 + bi) * 3072 + col); sc += *(const f32x4*)(adaP + (size_t)(kc * 9 + bi) * 3072 + 1024 + col); }
                        *(f32x4*)(AB1 + col) = *(const f32x4*)(P.norm_g + col) * (1.0f + sc); *(f32x4*)(AB1 + 1024 + col) = sh; }
                    __syncthreads(); AB = AB1; }
                f32x4 xv[4][4];
#pragma unroll
                for (int r = 0; r < 4; ++r) { const int m = m0 + wave * 4 + r; const float* xrow = pr ? P.x_prompt + (size_t)m * DM : P.x_sample + (size_t)(m - SEQ) * DM;
#pragma unroll
                    for (int j = 0; j < 4; ++j) xv[r][j] = *(const f32x4*)(xrow + 4 * lane + 256 * j); }
                float lfv[4];
#pragma unroll
                for (int r = 0; r < 4; ++r) {
                    const int m = m0 + wave * 4 + r;
                    float ss = 0.f;
#pragma unroll
                    for (int j = 0; j < 4; ++j) { const f32x4 v = xv[r][j]; ss += (v[0] * v[0] + v[1] * v[1]) + (v[2] * v[2] + v[3] * v[3]); }
                    const float rs = 1.0f / sqrtf(wave_sum(ss) * (1.0f / DM) + EPS);
                    float f[8];
#pragma unroll
                    for (int e = 0; e < 8; ++e) f[e] = 0.f;
#pragma unroll
                    for (int j = 0; j < 4; ++j) { const int col = 4 * lane + 256 * j;
                        const f32x4 hv = (xv[r][j] * rs) * *(const f32x4*)(AB + col) + *(const f32x4*)(AB + 1024 + col);
                        u32x2 w; w.x = pk2(hv[0], hv[1]); w.y = pk2(hv[2], hv[3]); *(u32x2*)(XN + (size_t)m * DM + col) = w;
#pragma unroll
                        for (int i = 0; i < 4; ++i) { const f32x4 w0 = *(const f32x4*)(wfs + (((j * 4 + i) * 2 + 0) * 64 + lane) * 4), w1 = *(const f32x4*)(wfs + (((j * 4 + i) * 2 + 1) * 64 + lane) * 4);
                            f[0] += hv[i] * w0[0]; f[1] += hv[i] * w0[1]; f[2] += hv[i] * w0[2]; f[3] += hv[i] * w0[3]; f[4] += hv[i] * w1[0]; f[5] += hv[i] * w1[1]; f[6] += hv[i] * w1[2]; f[7] += hv[i] * w1[3]; } }
                    { const bool b5 = (lane & 32) != 0, b4 = (lane & 16) != 0, b3 = (lane & 8) != 0; float g4[4], g2[2], g1;
#pragma unroll
                        for (int e = 0; e < 4; ++e) { const float keep = b5 ? f[e + 4] : f[e], send = b5 ? f[e] : f[e + 4]; g4[e] = keep + __shfl_xor(send, 32); }
#pragma unroll
                        for (int e = 0; e < 2; ++e) { const float keep = b4 ? g4[e + 2] : g4[e], send = b4 ? g4[e] : g4[e + 2]; g2[e] = keep + __shfl_xor(send, 16); }
                        { const float keep = b3 ? g2[1] : g2[0], send = b3 ? g2[0] : g2[1]; g1 = keep + __shfl_xor(send, 8); }
                        g1 += __shfl_xor(g1, 4); g1 += __shfl_xor(g1, 2); g1 += __shfl_xor(g1, 1);
                        lfv[r] = g1; }
                }
                if ((lane & 7) == 0) { const int e = lane >> 3; const float bfv = P.b_f[e];
#pragma unroll
                    for (int r = 0; r < 4; ++r) { const int m = m0 + wave * 4 + r; const float z = lfv[r] + bfv; const float lf = fminf(z, 0.f) - log1pf(__expf(-fabsf(z)));
                        lfs[(wave * 4 + r) * 8 + e] = lf;
                        if (pr) P.out[O_LFP + (size_t)m * 8 + e] = lf; else P.out[O_LFS + (size_t)(m - SEQ) * 8 + e] = lf; } }
                __syncthreads();
                if (tid < 8) { float a = 0.f; for (int r = 0; r < 32; ++r) { a += lfs[r * 8 + tid]; GT2[(size_t)tid * MT + m0 + r] = a * LOG2E; } TP2[unit * 8 + tid] = a * LOG2E; }
                __syncthreads();
            } else {
                const int cu = unit - NCHUNK, b = cu >> 5, s0 = (cu & 31) * 32;
                if (tid < 8) { float lv[32];
#pragma unroll
                    for (int r = 0; r < 32; ++r) lv[r] = P.cache_logf[(size_t)(b * PAST + s0 + r) * 8 + tid];
                    float a = 0.f;
#pragma unroll
                    for (int r = 0; r < 32; ++r) { a += lv[r]; GC2[(size_t)(b * 8 + tid) * PAST + s0 + r] = a * LOG2E; } TC2[cu * 8 + tid] = a * LOG2E; }
                float mx = 0.f; f32x4 ka[4], kc4[4];
#pragma unroll
                for (int r = 0; r < 4; ++r) { const float* kp = P.cache_k + (size_t)(b * PAST + s0 + wave * 4 + r) * 512 + 8 * lane; ka[r] = *(const f32x4*)kp; kc4[r] = *(const f32x4*)(kp + 4); }
#pragma unroll
                for (int r = 0; r < 4; ++r) { const f32x4 a = ka[r], c = kc4[r];
                    float s = (a[0] * a[0] + a[1] * a[1]) + (a[2] * a[2] + a[3] * a[3]) + (c[0] * c[0] + c[1] * c[1]) + (c[2] * c[2] + c[3] * c[3]);
                    s += __shfl_xor(s, 1); s += __shfl_xor(s, 2); s += __shfl_xor(s, 4); mx = fmaxf(mx, s); }
                if ((lane & 7) == 0) atomicMax(kcmax + (lane >> 3), __float_as_uint(mx));
            }
        }
        __syncthreads();
        if (bid >= 16) {
            float* scr = ldsf + wave * 4096;
            const int gw = (bid - 16) * 8 + wave, NGW = (G - 16) * 8;
            for (int it = gw; it < 2080; it += NGW) {
                if (it < 1536) { const int kb = it / 96, nb = it % 96, n0 = 32 * nb; tr_item(P.w_in, INC, 64 * kb, n0 < 2048 ? n0 : n0 + 8, WIN, 1024, n0, scr, lane); }
                else if (it < 2048) { const int r = it - 1536, kb = r / 32, nb = r % 32; tr_item(P.w_out, 1024, 64 * kb, 32 * nb, WOUT, 1024, 32 * nb, scr, lane); }
                else { const int r = it - 2048, g = r >> 3, kb = (r >> 2) & 1, nb = r & 3; tr_item(P.w_pool + (size_t)g * 128 * 128, 128, 64 * kb, 32 * nb, WP + (size_t)g * 128 * 128, 128, 32 * nb, scr, lane); }
            }
        }
    }
    xcd_barrier(bar);
    TP(2);

    {
        pg8::Gemm g{XN, WIN, MT, NPJ, DM}; pg8::StaticOrder S; S.init(SEQ, NPJ, G, bid); S.rep = REP_P2;
        pg8::EpiProj E{PB, P.out, qkmax, VT, (LAS unsigned char*)lds + 131072};
        static_assert(O_KP == 17301504 && O_KS == 34217472 && O_VP == 25690112 && O_VS == 34479616, "d_out map");
        pg8::gemm_phase<pg8::EpiProj, pg8::StaticOrder, true, true>((LAS unsigned char*)lds, g, S, E);
    }
    xcd_barrier(bar);
    TP(3);

    if (G == 256) {
        const int r32 = lane & 31, h2 = lane >> 5;
        unsigned* sigA = ctlu + CW_SIGA;
        unsigned* sigB = ctlu + CW_SIGB;
#define SIGNAL(sig) do { asm volatile("s_waitcnt vmcnt(0)" ::: "memory"); __syncthreads(); if (tid == 0) { __builtin_amdgcn_fence(__ATOMIC_RELEASE, "agent"); asm volatile("s_waitcnt vmcnt(0)" ::: "memory"); (void)__hip_atomic_fetch_add(sig, 1u, __ATOMIC_RELAXED, __HIP_MEMORY_SCOPE_AGENT); } } while (0)
#define WAITSIG(sig, n) do { if (tid == 0) { unsigned sp_ = 0; while (__hip_atomic_load(sig, __ATOMIC_RELAXED, __HIP_MEMORY_SCOPE_AGENT) < (n)) { __builtin_amdgcn_s_sleep(8); if (++sp_ > (1u << 20)) break; } __builtin_amdgcn_fence(__ATOMIC_ACQUIRE, "agent"); asm volatile("s_waitcnt vmcnt(0)" ::: "memory"); } __syncthreads(); } while (0)
        if (bid >= 232) {
            const int k = bid - 232;
            pg8::Gemm g{XN, WIN, MT, NPJ, DM}; pg8::OneUnit S{64 + k / 12, k % 12};
            pg8::EpiProj E{PB, P.out, qkmax, VT, (LAS unsigned char*)lds + 131072};
            pg8::gemm_phase<pg8::EpiProj, pg8::OneUnit, true, true>((LAS unsigned char*)lds, g, S, E);
            { unsigned* sg = ctlu + CW_SIGB + 64 + 64 * ((k / 12) * 2 + ((k % 12) >= 8 ? 1 : 0)); SIGNAL(sg); }
        }
        const int gwv = bid * 8 + wave;
        unsigned ulist[3]; int nun = 0;
#pragma unroll
        for (int k = 0; k < 3; ++k) { unsigned u = 0xffffffffu; const int xcd = bid & 7;
            if (bid < 64) { if (k == 0) u = (unsigned)((xcd * 8 + (bid >> 3)) * 8 + wave); }
            else if (bid < 72) { }
            else if (bid < 80) { if (k == 0) u = (unsigned)((64 + (bid - 72)) * 8 + wave); }
            else if (bid >= 232) { if (k == 0) u = (unsigned)((72 + xcd * 3 + ((bid - 232) >> 3)) * 8 + wave); }
            else { const int vn = xcd * 19 + ((bid - 80) >> 3); const int nch = vn < 112 ? 3 : 2, c0 = vn < 112 ? 96 + 3 * vn : 432 + 2 * (vn - 112); if (k < nch) u = (unsigned)((c0 + k) * 8 + wave); }
            ulist[k] = u; if (u != 0xffffffffu) nun = k + 1; }
#pragma unroll 1
        for (int pi = 0; pi < 2; ++pi) {
            const unsigned ua = pi == 0 ? ulist[0] : ulist[2]; const unsigned ub = pi == 0 ? ulist[1] : 0xffffffffu;
            if (ua == 0xffffffffu) break;
            const bool hasb = ub != 0xffffffffu;
            const int cqa = (int)(ua >> 3), hda = (int)(ua & 7), q0a = cqa * 32;
            const int cqb = hasb ? (int)(ub >> 3) : cqa, hdb = hasb ? (int)(ub & 7) : hda, q0b = cqb * 32;
            const float qkba = 2.0f * 1.02f * SC2 * sqrtf((__uint_as_float(qkmax[2 * hda]) + __uint_as_float(qkmax[2 * hda + 1])) * (__uint_as_float(qkmax[16 + 2 * hda]) + __uint_as_float(qkmax[16 + 2 * hda + 1])));
            const float qkbb = 2.0f * 1.02f * SC2 * sqrtf((__uint_as_float(qkmax[2 * hdb]) + __uint_as_float(qkmax[2 * hdb + 1])) * (__uint_as_float(qkmax[16 + 2 * hdb]) + __uint_as_float(qkmax[16 + 2 * hdb + 1])));
            bf16x8* qla = (bf16x8*)(lds + wave * 8192); bf16x8* qlb = qla + 256;
            const float gqa = GT2[(size_t)hda * MT + q0a + r32], gqb_ = GT2[(size_t)hdb * MT + q0b + r32];
            AttnState sa, sb; sa.m = -INFINITY; sa.l = 0.f; sa.o0 = f32x16{}; sa.o1 = f32x16{}; sb.m = -INFINITY; sb.l = 0.f; sb.o0 = f32x16{}; sb.o1 = f32x16{};
            TileRegs TA, TB;
            tile_load(TA, PB + (size_t)q0a * 3072 + PB_K + hda * 64, VT + (size_t)(hda * 64) * MT + q0a, GT2 + (size_t)hda * MT + q0a, lane);
            if (hasb) tile_load(TB, PB + (size_t)q0b * 3072 + PB_K + hdb * 64, VT + (size_t)(hdb * 64) * MT + q0b, GT2 + (size_t)hdb * MT + q0b, lane);
            { bf16x8 qt[4]; load_q(qt, PB, q0a, hda, lane);
#pragma unroll
                for (int d0 = 0; d0 < 4; ++d0) qla[d0 * 64 + lane] = qt[d0];
                load_q(qt, PB, q0b, hdb, lane);
#pragma unroll
                for (int d0 = 0; d0 < 4; ++d0) qlb[d0 * 64 + lane] = qt[d0]; }
            asm volatile("" ::: "memory");
            tile_compute<true>(sa, qla, gqa, TA, lane);
            if (hasb) tile_compute<true>(sb, qlb, gqb_, TB, lane);
            int cka = cqa - 1, ckb = hasb ? cqb - 1 : -1; float basea = 0.f, baseb = 0.f;
            float tva = 0.f, tvb = 0.f; { const int ca = cka - lane, cb = ckb - lane; if (ca >= 0) tva = TP2[ca * 8 + hda]; if (cb >= 0) tvb = TP2[cb * 8 + hdb]; }
            int ia = 0, ib = 0;
            for (;;) {
                const bool ma = cka >= 0 && !(basea + qkba < -THR2), mb = ckb >= 0 && !(baseb + qkbb < -THR2);
                if (!ma && !mb) break;
                if (ma) { basea += __uint_as_float(__builtin_amdgcn_readlane(__float_as_uint(tva), ia & 63)); ++ia;
                    if ((ia & 63) == 0) { const int ca = cka - 1 - lane; tva = ca >= 0 ? TP2[ca * 8 + hda] : 0.f; }
                    tile_load(TA, PB + (size_t)cka * 32 * 3072 + PB_K + hda * 64, VT + (size_t)(hda * 64) * MT + cka * 32, GT2 + (size_t)hda * MT + cka * 32, lane); }
                if (mb) { baseb += __uint_as_float(__builtin_amdgcn_readlane(__float_as_uint(tvb), ib & 63)); ++ib;
                    if ((ib & 63) == 0) { const int cb = ckb - 1 - lane; tvb = cb >= 0 ? TP2[cb * 8 + hdb] : 0.f; }
                    tile_load(TB, PB + (size_t)ckb * 32 * 3072 + PB_K + hdb * 64, VT + (size_t)(hdb * 64) * MT + ckb * 32, GT2 + (size_t)hdb * MT + ckb * 32, lane); }
                asm volatile("" ::: "memory");
                if (ma) { tile_compute<false>(sa, qla, gqa + basea, TA, lane); --cka; } else cka = -1;
                if (mb) { tile_compute<false>(sb, qlb, gqb_ + baseb, TB, lane); --ckb; } else ckb = -1;
            }
            attn_finish(sa, sa.l + __shfl_xor(sa.l, 32), PB, Z, q0a, hda, lane);
            if (hasb) attn_finish(sb, sb.l + __shfl_xor(sb.l, 32), PB, Z, q0b, hdb, lane);
        }
        (void)nun;
        __syncthreads();
        if (bid < 72) { const int pmx = bid < 64 ? (bid >> 5) : ((bid - 64) >> 2); unsigned* sg = ctlu + CW_SIGB + 64 + 64 * (pmx * 2 + (bid < 64 ? 0 : 1)); const unsigned need = bid < 64 ? 8u : 4u; WAITSIG(sg, need); }
        if (bid < 64) {
            const int b = bid >> 3, hd = bid & 7, qc = wave & 1, sp = wave >> 1;
            const int q0 = SEQ + b * 64 + 32 * qc;
            const float qm2 = __uint_as_float(qkmax[2 * hd]) + __uint_as_float(qkmax[2 * hd + 1]);
            const float km2 = fmaxf(__uint_as_float(qkmax[16 + 2 * hd]) + __uint_as_float(qkmax[16 + 2 * hd + 1]), __uint_as_float(kcmax[hd]));
            const float qkb2 = 2.0f * 1.02f * SC2 * sqrtf(qm2 * km2);
            bf16x8 qr[4]; load_q(qr, PB, q0, hd, lane);
            const float gq = GT2[(size_t)hd * MT + q0 + r32];
            AttnState st; st.m = -INFINITY; st.l = 0.f; st.o0 = f32x16{}; st.o1 = f32x16{};
            float base = 0.f; int i = 1;
            if (sp == 0) attn_tile<false, true>(st, qr, gq, PB + (size_t)q0 * 3072 + PB_K + hd * 64, VT + (size_t)(hd * 64) * MT + q0, GT2 + (size_t)hd * MT + q0, lane);
            if (qc == 1) { base += TP2[(512 + 2 * b) * 8 + hd];
                if (sp == 1) attn_tile<false, false>(st, qr, gq + base, PB + (size_t)(q0 - 32) * 3072 + PB_K + hd * 64, VT + (size_t)(hd * 64) * MT + q0 - 32, GT2 + (size_t)hd * MT + q0 - 32, lane);
                i = 2; }
            const float tvc = (lane < 32) ? TC2[(b * 32 + 31 - lane) * 8 + hd] : 0.f;
            for (int c = 31; c >= 0; --c, ++i) {
                if (base + qkb2 < -THR2) break;
                base += __uint_as_float(__builtin_amdgcn_readlane(__float_as_uint(tvc), 31 - c));
                if ((i & 3) == sp) attn_tile<true, false>(st, qr, gq + base, P.cache_k + ((size_t)(b * PAST + c * 32) * 8 + hd) * 64, P.cache_v + ((size_t)(b * PAST + c * 32) * 8 + hd) * 64, GC2 + (size_t)(b * 8 + hd) * PAST + c * 32, lane);
            }
            float lt = st.l + __shfl_xor(st.l, 32);
            float* mine = ldsf + wave * (34 * 64);
            mine[lane] = st.m; mine[64 + lane] = lt;
#pragma unroll
            for (int r = 0; r < 16; ++r) { mine[(2 + r) * 64 + lane] = st.o0[r]; mine[(18 + r) * 64 + lane] = st.o1[r]; }
            __syncthreads();
            if (sp == 0) {
                float mt = st.m;
#pragma unroll
                for (int s = 1; s < 4; ++s) mt = fmaxf(mt, ldsf[(wave + 2 * s) * (34 * 64) + lane]);
                const float a0 = __builtin_amdgcn_exp2f(st.m - mt);
                lt *= a0;
#pragma unroll
                for (int r = 0; r < 16; ++r) { st.o0[r] *= a0; st.o1[r] *= a0; }
#pragma unroll
                for (int s = 1; s < 4; ++s) { const float* oth = ldsf + (wave + 2 * s) * (34 * 64); const float as = __builtin_amdgcn_exp2f(oth[lane] - mt);
                    lt += as * oth[64 + lane];
#pragma unroll
                    for (int r = 0; r < 16; ++r) { st.o0[r] += as * oth[(2 + r) * 64 + lane]; st.o1[r] += as * oth[(18 + r) * 64 + lane]; } }
                attn_finish(st, lt, PB, Z, q0, hd, lane);
            }
            __syncthreads();
        }
        if (bid < 64) SIGNAL(sigB);
#pragma unroll 1
        for (int pi = (bid >= 64 && bid < 72) ? 0 : 1; pi < 2; ++pi) { const int unit = pi == 0 ? 192 + bid : bid;
            bf16* Ul = (bf16*)lds;
            bf16* Dl = (bf16*)(lds + 80896);
            const int r0 = unit * 64; const bool pr = r0 < SEQ; const int bb = pr ? 0 : (r0 - SEQ) >> 6;
            {
#pragma unroll
                for (int qb = 0; qb < 2; ++qb) { u32x4 sv[4];
#pragma unroll
                    for (int q = 0; q < 4; ++q) { const int i = tid + 512 * (4 * qb + q), rr = i >> 6, ch = i & 63; sv[q] = *(const u32x4*)(PB + (size_t)(r0 + rr) * 3072 + PB_U + 8 * ch); }
#pragma unroll
                    for (int q = 0; q < 4; ++q) { const int i = tid + 512 * (4 * qb + q); *(u32x4*)(Ul + (15 + (i >> 6)) * 512 + 8 * (i & 63)) = sv[q]; } }
                u32x4 hv[2] = {(u32x4){0u, 0u, 0u, 0u}, (u32x4){0u, 0u, 0u, 0u}};
#pragma unroll
                for (int q = 0; q < 2; ++q) { const int i = tid + 512 * q; if (i < 15 * 64) { const int rr = i >> 6, ch = i & 63, l = rr - 15;
                    if (pr) { if (r0 + l >= 0) hv[q] = *(const u32x4*)(PB + (size_t)(r0 + l) * 3072 + PB_U + 8 * ch); }
                    else { const float* hp = P.state_pool + (size_t)(bb * 15 + rr) * 512 + 8 * ch; const f32x4 a = *(const f32x4*)hp, b = *(const f32x4*)(hp + 4);
                        hv[q].x = pk2(a[0], a[1]); hv[q].y = pk2(a[2], a[3]); hv[q].z = pk2(b[0], b[1]); hv[q].w = pk2(b[2], b[3]); } } }
#pragma unroll
                for (int q = 0; q < 2; ++q) { const int i = tid + 512 * q; if (i < 15 * 64) *(u32x4*)(Ul + (i >> 6) * 512 + 8 * (i & 63)) = hv[q]; } }
            __syncthreads();
            {
                const int c = tid, w = 2 << (c >> 7);
                const bf16* ucol = Ul + 15 * 512 + c;
                const float invw = 1.0f / (float)w;
                float S = 0.f;
                for (int k = 1; k < w; ++k) S += bf2f(ucol[-k * 512]);
#pragma unroll 8
                for (int t = 0; t < 64; ++t) {
                    const float u = bf2f(ucol[t * 512]);
                    S += u;
                    float mean;
                    if (pr) { const int pos = r0 + t; mean = (pos + 1 < w) ? S / (float)(pos + 1) : S * invw; } else mean = S * invw;
                    Dl[t * 520 + c] = (bf16)(cvtpk(mean - u, 0.f) & 0xffffu);
                    S -= bf2f(ucol[(t - w + 1) * 512]);
                }
                if (unit == SEQ / 64 - 1) { for (int t = 0; t < 15; ++t) P.out[O_PP + (size_t)t * 512 + c] = bf2f(ucol[(49 + t) * 512]); }
                if (!pr) { for (int t = 0; t < 15; ++t) P.out[O_PS + (size_t)(bb * 15 + t) * 512 + c] = bf2f(ucol[(49 + t) * 512]); }
            }
            __syncthreads();
            {
                const int rb = wave & 1, g = wave >> 1;
                f32x16 acc[4];
#pragma unroll
                for (int nb = 0; nb < 4; ++nb) acc[nb] = f32x16{};
#pragma unroll
                for (int ks = 0; ks < 8; ++ks) { const bf16x8 a = *(const bf16x8*)(Dl + (32 * rb + r32) * 520 + g * 128 + 16 * ks + 8 * h2);
#pragma unroll
                    for (int nb = 0; nb < 4; ++nb) { const bf16x8 bw = *(const bf16x8*)(WP + ((size_t)(g * 128 + 32 * nb + r32)) * 128 + 16 * ks + 8 * h2);
                        acc[nb] = __builtin_amdgcn_mfma_f32_32x32x16_bf16(bw, a, acc[nb], 0, 0, 0); } }
                const int m = r0 + 32 * rb + r32;
#pragma unroll
                for (int nb = 0; nb < 4; ++nb) { u32x2 pgv[4]; f32x4 psv[4];
#pragma unroll
                    for (int i = 0; i < 4; ++i) { const int j = g * 128 + 32 * nb + 8 * i + 4 * h2; pgv[i] = *(const u32x2*)(PB + (size_t)m * 3072 + PB_PG + j); psv[i] = *(const f32x4*)(P.pool_scale + j); }
#pragma unroll
                    for (int i = 0; i < 4; ++i) { const int j = g * 128 + 32 * nb + 8 * i + 4 * h2; const u32x2 a = pgv[i];
                        const float a0 = __uint_as_float(a.x << 16), a1 = __uint_as_float(a.x & 0xffff0000u), a2 = __uint_as_float(a.y << 16), a3 = __uint_as_float(a.y & 0xffff0000u);
                        u32x2 w; w.x = cvtpk(acc[nb][4 * i + 0] * psv[i][0] * silu_f(a0), acc[nb][4 * i + 1] * psv[i][1] * silu_f(a1)); w.y = cvtpk(acc[nb][4 * i + 2] * psv[i][2] * silu_f(a2), acc[nb][4 * i + 3] * psv[i][3] * silu_f(a3));
                        *(u32x2*)(Z + (size_t)m * 1024 + 512 + j) = w; } }
            }
            __syncthreads();
            if (pi == 0) SIGNAL(sigB);
        }
        if (bid >= 72 && bid < 80) {
            WAITSIG(sigB, 72u);
            const int j = bid - 72;
            pg8::Gemm g{Z, WOUT, MT, DM, DM}; pg8::OneUnit S{64 + (j >> 2), j & 3};
            pg8::EpiMerge E{P.x_prompt, P.x_sample, P.out + O_YP, P.out + O_YS, adaG, P.final_g, rowss, pcnt};
            pg8::gemm_phase<pg8::EpiMerge, pg8::OneUnit, true, true>((LAS unsigned char*)lds, g, S, E);
        }
#undef SIGNAL
#undef WAITSIG
    }
    xcd_barrier(bar);
    TP(4);

    {
        pg8::Gemm g{Z, WOUT, MT, DM, DM}; pg8::MergeOrder S{bid, G};
        pg8::EpiMerge E{P.x_prompt, P.x_sample, P.out + O_YP, P.out + O_YS, adaG, P.final_g, rowss, pcnt};
        pg8::gemm_phase<pg8::EpiMerge, pg8::MergeOrder, true, true>((LAS unsigned char*)lds, g, S, E);
    }
    TP(5);
    if (TPROBE && bid == 0) {
        const float eps = (float)(tp1 - tp0) * 1e-5f;
        for (int i = tid; i < 4096; i += 512) P.out[O_LFS + i] *= (1.0f + eps);
    }
}

extern "C" void kernel_launch(void* const* d_in, const int* in_sizes, int n_in, void* d_out, int out_size, void* d_ws, size_t ws_size, hipStream_t stream) {
    static int grid = 0;
    if (grid == 0) {
        if (n_in != 17 || (size_t)out_size != O_END || ws_size < WS_END) { fprintf(stderr, "kernel_launch: unexpected problem shape (n_in %d, out %d, ws %zu)\n", n_in, out_size, ws_size); grid = -1; return; }
        int dev = 0, cus = 0, per_cu = 0;
        hipGetDevice(&dev); hipDeviceGetAttribute(&cus, hipDeviceAttributeMultiprocessorCount, dev);
        hipFuncSetAttribute((const void*)fox_pool_fwd, hipFuncAttributeMaxDynamicSharedMemorySize, LDS_BYTES);
        hipOccupancyMaxActiveBlocksPerMultiprocessor(&per_cu, (const void*)fox_pool_fwd, 512, LDS_BYTES);
        (void)hipGetLastError();
        if (per_cu < 1) { fprintf(stderr, "kernel_launch: occupancy query reports %d blocks per CU\n", per_cu); per_cu = 1; }
        grid = cus * 1;
        if (grid != 256) fprintf(stderr, "kernel_launch: this build's phase program is dealt for a 256-workgroup grid (256 CUs); found %d CUs\n", cus);
    }
    if (grid < 0) return;
    hipMemsetAsync((char*)d_ws + WS_CTL, 0, CTL_BYTES, stream);
    Params p{};
    const float** pp = (const float**)&p;
    for (int i = 0; i < 17; ++i) pp[i] = (const float*)d_in[i];
    p.out = (float*)d_out; p.ws = (unsigned char*)d_ws;
    void* args[] = {&p};
    hipError_t e = hipLaunchCooperativeKernel((const void*)fox_pool_fwd, dim3(grid), dim3(512), args, LDS_BYTES, stream);
    if (e != hipSuccess) fprintf(stderr, "cooperative launch failed: %s (grid %d)\n", hipGetErrorString(e), grid);
}
```

```cpp
#include <hip/hip_runtime.h>
#include <hip/hip_cooperative_groups.h>
#include <cstdio>
#include <cstdint>
namespace cg = cooperative_groups;
namespace pg8 {
#define PG8_LAS __attribute__((address_space(3)))
typedef unsigned short bf16_t;
typedef short bf16x8 __attribute__((ext_vector_type(8)));
typedef float f32x4 __attribute__((ext_vector_type(4)));
typedef unsigned u32x4 __attribute__((ext_vector_type(4)));
constexpr int BM = 256, BK = 64, HALF = 128, HTB = HALF * BK * 2  , STAGE_BYTES = 8 * HTB, NXCD = 8, WGM = 8;

__host__ __device__ __forceinline__ int lds_byte(int r, int c) { const int st = (r >> 4) * 2 + (c >> 5), rr = r & 15, cc = c & 31, ob = rr * 64 + cc * 2; return st * 1024 + (ob ^ (((ob >> 9) & 1) << 5)); }
__host__ __device__ __forceinline__ void stage_rc(int b, int& R, int& C) { const int st = b / 1024, sb = b % 1024, swz = sb ^ (((sb >> 9) & 1) << 5); R = (st >> 1) * 16 + swz / 64; C = (st & 1) * 32 + (swz % 64) / 2; }
__host__ __device__ __forceinline__ int perm32(int rho) { const int n = rho >> 4, i = rho & 15; return 8 * (i >> 2) + 4 * n + (i & 3); }

struct Unit { int pm, pn; };
struct Gemm { const bf16_t* A; const bf16_t* Bt; int M, N, K; };

struct StaticOrder {
    int nM, nN, nwg, G, c, rep = 1;
    __host__ __device__ void init(int M, int N, int G_, int c_) { nM = M / BM; nN = N / BM; nwg = nM * nN; G = G_; c = c_; }
    __host__ __device__ bool next(int i, Unit& u) const {
        const long L = (long)i * G + c; if (L >= (long)nwg * rep) return false;
        int wgid = (int)(L % nwg); { const int q = nwg / NXCD, r = nwg % NXCD, xcd = wgid % NXCD, off = wgid / NXCD; wgid = (xcd < r ? xcd * (q + 1) : r * (q + 1) + (xcd - r) * q) + off; }
        const int nig = WGM * nN, gid = wgid / nig, fm = gid * WGM, gsz = (nM - fm) < WGM ? (nM - fm) : WGM;
        u.pm = fm + ((wgid % nig) % gsz); u.pn = (wgid % nig) / gsz; return true;
    }
    __device__ __forceinline__ void a_ready(const Unit&) const {}
    __device__ __forceinline__ void done(const Unit&) const {}
};

__device__ __forceinline__ unsigned cvt_pk_bf16(float lo, float hi) { unsigned r; asm volatile("v_cvt_pk_bf16_f32 %0, %1, %2" : "=v"(r) : "v"(lo), "v"(hi)); return r; }

struct EpiProj {
    static constexpr bool PERM = true, AFTER_DRAIN = false;
    bf16_t* PB; float* out; unsigned* qkmax; bf16_t* VT; PG8_LAS unsigned char* scr;
    __device__ __forceinline__ void operator()(const f32x4 (&acc)[2][2][4][2], const Unit& u, int wr, int wc, int fr, int fq) const {
        const int row0 = u.pm * BM + wr * 64 + fr; const int col0 = u.pn * BM + wc * 32 + 8 * fq;
        if (u.pn < 4 || u.pn >= 6)
#pragma unroll
        for (int ai = 0; ai < 2; ++ai)
#pragma unroll
            for (int m = 0; m < 4; ++m) { bf16_t* rowp = PB + (size_t)(row0 + ai * HALF + m * 16) * 3072 + col0;
#pragma unroll
                for (int bj = 0; bj < 2; ++bj) { const f32x4 v0 = acc[ai][bj][m][0], v1 = acc[ai][bj][m][1];
                    u32x4 w; w.x = cvt_pk_bf16(v0[0], v0[1]); w.y = cvt_pk_bf16(v0[2], v0[3]); w.z = cvt_pk_bf16(v1[0], v1[1]); w.w = cvt_pk_bf16(v1[2], v1[3]);
                    *(u32x4*)(rowp + bj * HALF) = w; } }
        if (u.pn >= 2 && u.pn < 6) {
            const size_t obase = (u.pn < 4) ? (u.pm < 64 ? (size_t)17301504 : (size_t)34217472) : (u.pm < 64 ? (size_t)25690112 : (size_t)34479616);
            float* base = out + obase;
            const int rowl = (u.pm < 64 ? u.pm : u.pm - 64) * BM + wr * 64 + fr; const int colf = (u.pn & 1) * BM + wc * 32 + 8 * fq;
#pragma unroll
            for (int ai = 0; ai < 2; ++ai)
#pragma unroll
                for (int m = 0; m < 4; ++m) { float* rp = base + (size_t)(rowl + ai * HALF + m * 16) * 512 + colf;
#pragma unroll
                    for (int bj = 0; bj < 2; ++bj) { *(f32x4*)(rp + bj * HALF) = acc[ai][bj][m][0]; *(f32x4*)(rp + bj * HALF + 4) = acc[ai][bj][m][1]; } }
        }
        if (u.pn >= 4 && u.pn < 6) {
            const int lane = fr + 16 * fq; PG8_LAS unsigned short* w = (PG8_LAS unsigned short*)(scr + (wr * 4 + wc) * 2048);
#pragma unroll
            for (int ai = 0; ai < 2; ++ai)
#pragma unroll
                for (int m = 0; m < 4; ++m) {
#pragma unroll
                    for (int bj = 0; bj < 2; ++bj) {
#pragma unroll
                        for (int n = 0; n < 2; ++n)
#pragma unroll
                            for (int e = 0; e < 4; e += 2) { const unsigned pk = cvt_pk_bf16(acc[ai][bj][m][n][e], acc[ai][bj][m][n][e + 1]); const int ci = 8 * fq + 4 * n + e;
                                w[ci * 20 + fr] = (unsigned short)(pk & 0xffffu); w[(ci + 1) * 20 + fr] = (unsigned short)(pk >> 16); }
                        asm volatile("s_waitcnt lgkmcnt(0)" ::: "memory");
                        { const int ci = lane >> 1, hf = lane & 1;
                            typedef unsigned u32x2_t __attribute__((ext_vector_type(2)));
                            const u32x2_t lo = *(const PG8_LAS u32x2_t*)(w + ci * 20 + hf * 8), hi = *(const PG8_LAS u32x2_t*)(w + ci * 20 + hf * 8 + 4);
                            const int col = (u.pn - 4) * BM + bj * HALF + wc * 32 + ci; const int row = u.pm * BM + ai * HALF + wr * 64 + m * 16 + hf * 8;
                            u32x4 o; o.x = lo.x; o.y = lo.y; o.z = hi.x; o.w = hi.y; *(u32x4*)(VT + (size_t)col * 16896 + row) = o; }
                        asm volatile("s_waitcnt lgkmcnt(0)" ::: "memory");
                    }
                }
        }
        if (u.pn < 4) {
#pragma unroll
            for (int bj = 0; bj < 2; ++bj) { float mx = 0.f;
#pragma unroll
                for (int ai = 0; ai < 2; ++ai)
#pragma unroll
                    for (int m = 0; m < 4; ++m) { const f32x4 a = acc[ai][bj][m][0], b = acc[ai][bj][m][1];
                        float s = (a[0] * a[0] + a[1] * a[1]) + (a[2] * a[2] + a[3] * a[3]) + (b[0] * b[0] + b[1] * b[1]) + (b[2] * b[2] + b[3] * b[3]);
                        s += __shfl_xor(s, 16); s += __shfl_xor(s, 32); mx = fmaxf(mx, s); }
                mx = fmaxf(mx, __shfl_xor(mx, 1)); mx = fmaxf(mx, __shfl_xor(mx, 2)); mx = fmaxf(mx, __shfl_xor(mx, 4)); mx = fmaxf(mx, __shfl_xor(mx, 8));
                if (fr == 0 && fq == 0) atomicMax(qkmax + (u.pn * 8 + bj * 4 + wc), __float_as_uint(mx)); }
        }
    }
};
struct EpiMerge {
    static constexpr bool PERM = true, AFTER_DRAIN = false;
    const float* xp; const float* xs; float* yp; float* ys; const float* gate; const float* final_g; float* rowss; unsigned* pcnt;
    __device__ __forceinline__ void operator()(f32x4 (&acc)[2][2][4][2], const Unit& u, int wr, int wc, int fr, int fq) const {
        const bool pr = u.pm < 64; const int rowl = (pr ? u.pm : u.pm - 64) * BM + wr * 64 + fr;
        const float* xb = pr ? xp : xs; float* yb = pr ? yp : ys; const int col0 = u.pn * BM + wc * 32 + 8 * fq;
#pragma unroll
        for (int ai = 0; ai < 2; ++ai) {
            const int bi = pr ? 0 : 1 + (u.pm - 64) * 4 + 2 * ai + wr;
            f32x4 gt[2][2];
#pragma unroll
            for (int bj = 0; bj < 2; ++bj)
#pragma unroll
                for (int n = 0; n < 2; ++n) gt[bj][n] = *(const f32x4*)(gate + bi * 1024 + col0 + bj * HALF + 4 * n);
#pragma unroll
            for (int mp = 0; mp < 2; ++mp) {
            f32x4 xv[2][2][2];
#pragma unroll
            for (int m2 = 0; m2 < 2; ++m2) { const size_t off = (size_t)(rowl + ai * HALF + (2 * mp + m2) * 16) * 1024 + col0;
#pragma unroll
                for (int bj = 0; bj < 2; ++bj)
#pragma unroll
                    for (int n = 0; n < 2; ++n) xv[m2][bj][n] = *(const f32x4*)(xb + off + bj * HALF + 4 * n); }
#pragma unroll
            for (int m2 = 0; m2 < 2; ++m2) { const int m = 2 * mp + m2; float ss = 0.f;
#pragma unroll
                for (int bj = 0; bj < 2; ++bj)
#pragma unroll
                    for (int n = 0; n < 2; ++n) { const f32x4 o = xv[m2][bj][n] + gt[bj][n] * acc[ai][bj][m][n]; acc[ai][bj][m][n] = o; ss += (o[0] * o[0] + o[1] * o[1]) + (o[2] * o[2] + o[3] * o[3]); }
                ss += __shfl_xor(ss, 16); ss += __shfl_xor(ss, 32);
                if (fq == 0) (void)__hip_atomic_fetch_add(rowss + u.pm * BM + ai * HALF + wr * 64 + m * 16 + fr, ss, __ATOMIC_RELAXED, __HIP_MEMORY_SCOPE_AGENT); }
            asm volatile("" ::: "memory");
            }
        }
        asm volatile("s_waitcnt vmcnt(0)" ::: "memory");
        unsigned* pc = pcnt + 64 * (u.pm * 2 + wr);
        if (fr == 0 && fq == 0) (void)__hip_atomic_fetch_add(pc, 1u, __ATOMIC_RELAXED, __HIP_MEMORY_SCOPE_AGENT);
        { unsigned sp = 0; while ((unsigned)__builtin_amdgcn_readfirstlane(__hip_atomic_load(pc, __ATOMIC_RELAXED, __HIP_MEMORY_SCOPE_AGENT)) < 16u) { __builtin_amdgcn_s_sleep(8); if (++sp > (1u << 21)) break; } }
        asm volatile("" ::: "memory");
#pragma unroll
        for (int ai = 0; ai < 2; ++ai) {
            f32x4 fg[2][2];
#pragma unroll
            for (int bj = 0; bj < 2; ++bj)
#pragma unroll
                for (int n = 0; n < 2; ++n) fg[bj][n] = *(const f32x4*)(final_g + col0 + bj * HALF + 4 * n);
            float rs[4];
#pragma unroll
            for (int m = 0; m < 4; ++m) rs[m] = __hip_atomic_load(rowss + u.pm * BM + ai * HALF + wr * 64 + m * 16 + fr, __ATOMIC_RELAXED, __HIP_MEMORY_SCOPE_AGENT);
#pragma unroll
            for (int m = 0; m < 4; ++m) { const float r = 1.0f / sqrtf(rs[m] * (1.0f / 1024.0f) + 1e-6f); const size_t off = (size_t)(rowl + ai * HALF + m * 16) * 1024 + col0;
#pragma unroll
                for (int bj = 0; bj < 2; ++bj)
#pragma unroll
                    for (int n = 0; n < 2; ++n) *(f32x4*)(yb + off + bj * HALF + 4 * n) = acc[ai][bj][m][n] * r * fg[bj][n]; }
        }
    }
};
struct OneUnit {
    int pm, pn;
    __device__ bool next(int i, Unit& u) const { if (i > 0) return false; u.pm = pm; u.pn = pn; return true; }
    __device__ __forceinline__ void a_ready(const Unit&) const {}
    __device__ __forceinline__ void done(const Unit&) const {}
};
struct MergeOrder {
    int c, G;
    __device__ bool next(int i, Unit& u) const {
        const int L = i * G + c; if (L >= 256) return false;
        if (L < 256) { const int xcd = L & 7, off = L >> 3; u.pm = xcd * 8 + (off & 7); u.pn = off >> 3; } else { u.pm = 64 + ((L - 256) >> 2); u.pn = (L - 256) & 3; }
        return true; }
    __device__ __forceinline__ void a_ready(const Unit&) const {}
    __device__ __forceinline__ void done(const Unit&) const {}
};

template <class Epi, class Sched, bool ALIGN_EPI = false, bool SP2 = false>
__device__ __forceinline__ void gemm_phase(PG8_LAS unsigned char* lds, const Gemm g, const Sched& S, const Epi& E) {
    const int tid = threadIdx.x, wid = __builtin_amdgcn_readfirstlane(tid >> 6), lane = tid & 63, wr = wid >> 2, wc = wid & 3, fr = lane & 15, fq = lane >> 4;
    const int K = g.K, nt = K / BK;
    unsigned voffA[2], voffB[2];
#pragma unroll
    for (int i = 0; i < 2; ++i) { int R, C; stage_rc(tid * 16 + i * 8192, R, C); const int Rb = Epi::PERM ? ((R & ~31) + perm32(R & 31)) : R;
        voffA[i] = (unsigned)(R * K + C) * 2u; voffB[i] = (unsigned)(Rb * K + C) * 2u; }
    const size_t kstep = (size_t)(BK * 2);
    const size_t hstep = (size_t)HALF * K * 2;
    const size_t tstep = 2 * hstep;
    const unsigned ldsw = (unsigned)wid * 1024u;
    const int aoff = lds_byte(wr * 64 + fr, fq * 8), boff = lds_byte(wc * 32 + fr, fq * 8);
#define PG8_SA(b, h) (((b) * 2 + (h)) * HTB)
#define PG8_SB(b, h) ((4 + (b) * 2 + (h)) * HTB)
#define PG8_STAGE(bufoff, gbase, voff) do { _Pragma("unroll") for (int _i = 0; _i < 2; ++_i) \
        __builtin_amdgcn_global_load_lds((const unsigned*)((const char*)(gbase) + (voff)[_i]), (PG8_LAS unsigned*)(lds + (bufoff) + ldsw + _i * 8192), 16, 0, 0); } while (0)
#define PG8_LDA(dst, b, h) do { _Pragma("unroll") for (int m = 0; m < 4; ++m) _Pragma("unroll") for (int k = 0; k < 2; ++k) dst[m][k] = *(const PG8_LAS bf16x8*)(lds + PG8_SA(b, h) + aoff + m * 2048 + k * 1024); } while (0)
#define PG8_LDB(dst, b, h) do { _Pragma("unroll") for (int n = 0; n < 2; ++n) _Pragma("unroll") for (int k = 0; k < 2; ++k) dst[n][k] = *(const PG8_LAS bf16x8*)(lds + PG8_SB(b, h) + boff + n * 2048 + k * 1024); } while (0)
#define PG8_MMA(ai, bj, At, Bt) do { __builtin_amdgcn_s_setprio(1); _Pragma("unroll") for (int m = 0; m < 4; ++m) _Pragma("unroll") for (int n = 0; n < 2; ++n) _Pragma("unroll") for (int k = 0; k < 2; ++k) \
        acc[ai][bj][m][n] = __builtin_amdgcn_mfma_f32_16x16x32_bf16(Bt[n][k], At[m][k], acc[ai][bj][m][n], 0, 0, 0); __builtin_amdgcn_s_setprio(0); } while (0)
#define PG8_WAIT_V(n) asm volatile("s_waitcnt vmcnt(" #n ")" ::: "memory")
#define PG8_WAIT_L(n) asm volatile("s_waitcnt lgkmcnt(" #n ")" ::: "memory")
#define PG8_BAR __builtin_amdgcn_s_barrier()
#define PG8_SCHED __builtin_amdgcn_sched_barrier(0)
    Unit cur, nxt; int ui = 0;
    if (!S.next(0, cur)) return;
    f32x4 acc[2][2][4][2];
#pragma unroll
    for (int a = 0; a < 2; ++a)
#pragma unroll
        for (int b = 0; b < 2; ++b)
#pragma unroll
            for (int m = 0; m < 4; ++m)
#pragma unroll
                for (int n = 0; n < 2; ++n) acc[a][b][m][n] = (f32x4){0.f, 0.f, 0.f, 0.f};
    bf16x8 At[4][2], B0[2][2], B1[2][2];
    const char* cA = (const char*)g.A + (size_t)cur.pm * tstep; const char* cB = (const char*)g.Bt + (size_t)cur.pn * tstep;
    S.a_ready(cur);
    if constexpr (SP2) {
        PG8_STAGE(PG8_SB(0, 0), cB, voffB); PG8_STAGE(PG8_SB(0, 1), cB + hstep, voffB); PG8_STAGE(PG8_SA(0, 0), cA, voffA); PG8_STAGE(PG8_SA(0, 1), cA + hstep, voffA);
        if (wr == 1) PG8_BAR;
        PG8_WAIT_V(2); PG8_BAR;
        PG8_STAGE(PG8_SB(1, 0), cB + kstep, voffB); PG8_STAGE(PG8_SA(1, 0), cA + kstep, voffA); PG8_STAGE(PG8_SB(1, 1), cB + hstep + kstep, voffB);
        PG8_WAIT_V(6); PG8_BAR;
    } else {
        PG8_STAGE(PG8_SB(0, 0), cB, voffB); PG8_STAGE(PG8_SA(0, 0), cA, voffA); PG8_STAGE(PG8_SB(0, 1), cB + hstep, voffB); PG8_STAGE(PG8_SA(0, 1), cA + hstep, voffA);
        if (wr == 1) PG8_BAR;
        PG8_WAIT_V(4); PG8_BAR;
        PG8_STAGE(PG8_SB(1, 0), cB + kstep, voffB); PG8_STAGE(PG8_SA(1, 0), cA + kstep, voffA); PG8_STAGE(PG8_SB(1, 1), cB + hstep + kstep, voffB);
        PG8_WAIT_V(6); PG8_BAR;
    }
    for (;;) {
        const bool has_next = S.next(ui + 1, nxt);
        const char* nA = has_next ? (const char*)g.A + (size_t)nxt.pm * tstep : cA; const char* nB = has_next ? (const char*)g.Bt + (size_t)nxt.pn * tstep : cB;
        for (int t = 0; t < nt; t += 2) {
            const bool last = (t == nt - 2);
            const char* a1 = cA + (size_t)(t + 1) * kstep;
            const char* a2 = last ? nA : cA + (size_t)(t + 2) * kstep; const char* b2 = last ? nB : cB + (size_t)(t + 2) * kstep;
            const char* a3 = a2 + kstep; const char* b3 = b2 + kstep;
            if (last && has_next) S.a_ready(nxt);
            if constexpr (SP2) {
            PG8_LDB(B0, 0, 0); PG8_LDB(B1, 0, 1); PG8_SCHED; PG8_LDA(At, 0, 0); PG8_STAGE(PG8_SA(1, 1), a1 + hstep, voffA);
            PG8_WAIT_V(8); PG8_WAIT_L(0); PG8_BAR; PG8_MMA(0, 0, At, B0); PG8_MMA(0, 1, At, B1); PG8_BAR; PG8_SCHED;
            PG8_LDA(At, 0, 1); PG8_STAGE(PG8_SB(0, 0), b2, voffB); PG8_STAGE(PG8_SB(0, 1), b2 + hstep, voffB); PG8_STAGE(PG8_SA(0, 0), a2, voffA);
            PG8_WAIT_V(8); PG8_WAIT_L(0); PG8_BAR; PG8_MMA(1, 0, At, B0); PG8_MMA(1, 1, At, B1); PG8_BAR; PG8_SCHED;
            PG8_LDB(B0, 1, 0); PG8_LDB(B1, 1, 1); PG8_SCHED; PG8_LDA(At, 1, 0); PG8_STAGE(PG8_SA(0, 1), a2 + hstep, voffA);
            PG8_WAIT_V(8); PG8_WAIT_L(0); PG8_BAR; PG8_MMA(0, 0, At, B0); PG8_MMA(0, 1, At, B1); PG8_BAR; PG8_SCHED;
            PG8_LDA(At, 1, 1); PG8_STAGE(PG8_SB(1, 0), b3, voffB); PG8_STAGE(PG8_SB(1, 1), b3 + hstep, voffB); PG8_STAGE(PG8_SA(1, 0), a3, voffA);
            PG8_WAIT_V(8); PG8_WAIT_L(0); PG8_BAR; PG8_MMA(1, 0, At, B0); PG8_MMA(1, 1, At, B1); PG8_BAR; PG8_SCHED;
            } else {
            PG8_LDB(B0, 0, 0); PG8_SCHED; PG8_LDA(At, 0, 0); PG8_STAGE(PG8_SA(1, 1), a1 + hstep, voffA);
            PG8_WAIT_L(8); PG8_BAR; PG8_WAIT_L(0); PG8_MMA(0, 0, At, B0); PG8_BAR; PG8_SCHED;
            PG8_LDB(B1, 0, 1); PG8_STAGE(PG8_SB(0, 0), b2, voffB);
            PG8_BAR; PG8_WAIT_L(0); PG8_MMA(0, 1, At, B1); PG8_BAR;
            PG8_LDA(At, 0, 1); PG8_STAGE(PG8_SA(0, 0), a2, voffA);
            PG8_BAR; PG8_WAIT_L(0); PG8_MMA(1, 0, At, B0); PG8_BAR; PG8_SCHED;
            PG8_STAGE(PG8_SB(0, 1), b2 + hstep, voffB);
            PG8_WAIT_V(6); PG8_BAR; PG8_MMA(1, 1, At, B1); PG8_BAR;
            PG8_LDB(B0, 1, 0); PG8_SCHED; PG8_LDA(At, 1, 0); PG8_STAGE(PG8_SA(0, 1), a2 + hstep, voffA);
            PG8_WAIT_L(8); PG8_BAR; PG8_WAIT_L(0); PG8_MMA(0, 0, At, B0); PG8_BAR; PG8_SCHED;
            PG8_LDB(B1, 1, 1); PG8_STAGE(PG8_SB(1, 0), b3, voffB);
            PG8_BAR; PG8_WAIT_L(0); PG8_MMA(0, 1, At, B1); PG8_BAR;
            PG8_LDA(At, 1, 1); PG8_STAGE(PG8_SA(1, 0), a3, voffA);
            PG8_BAR; PG8_WAIT_L(0); PG8_MMA(1, 0, At, B0); PG8_BAR; PG8_SCHED;
            PG8_STAGE(PG8_SB(1, 1), b3 + hstep, voffB);
            PG8_WAIT_V(6); PG8_BAR; PG8_MMA(1, 1, At, B1); PG8_BAR;
            }
        }
        if constexpr (ALIGN_EPI) { if (wr == 0) PG8_BAR; }
        if constexpr (!Epi::AFTER_DRAIN) { E(acc, cur, wr, wc, fr, fq); S.done(cur); }
        if (!has_next) break;
#pragma unroll
        for (int a = 0; a < 2; ++a)
#pragma unroll
            for (int b = 0; b < 2; ++b)
#pragma unroll
                for (int m = 0; m < 4; ++m)
#pragma unroll
                    for (int n = 0; n < 2; ++n) acc[a][b][m][n] = (f32x4){0.f, 0.f, 0.f, 0.f};
        cur = nxt; cA = nA; cB = nB; ++ui;
        if constexpr (ALIGN_EPI) { if (wr == 1) PG8_BAR; }
    }
    PG8_WAIT_V(0);
    if constexpr (!ALIGN_EPI) { if (wr == 0) PG8_BAR; }
    PG8_BAR;
    if constexpr (Epi::AFTER_DRAIN) { E.fused(acc, cur, wr, wc, fr, fq, lds, wid, lane); S.done(cur); }
#undef PG8_SA
#undef PG8_SB
#undef PG8_STAGE
#undef PG8_LDA
#undef PG8_LDB
#undef PG8_MMA
#undef PG8_WAIT_V
#undef PG8_WAIT_L
#undef PG8_BAR
#undef PG8_SCHED
}
}

#ifndef REP_P0
#define REP_P0 1
#endif
#ifndef REP_P1
#define REP_P1 1
#endif
#ifndef REP_P2
#define REP_P2 1
#endif
#ifndef REP_P3
#define REP_P3 1
#endif
#ifndef REP_POOL
#define REP_POOL REP_P3
#endif
#ifndef REP_PA
#define REP_PA REP_P3
#endif
#ifndef REP_SA
#define REP_SA 1
#endif
#ifndef TPROBE
#define TPROBE 0
#endif
#ifndef REP_P4
#define REP_P4 1
#endif
#ifndef XSYNC
#define XSYNC 0
#endif
typedef unsigned short bf16;
typedef short bf16x8 __attribute__((ext_vector_type(8)));
typedef float f32x4 __attribute__((ext_vector_type(4)));
typedef float f32x16 __attribute__((ext_vector_type(16)));
typedef unsigned u32x4 __attribute__((ext_vector_type(4)));
typedef unsigned u32x2 __attribute__((ext_vector_type(2)));
#define LAS __attribute__((address_space(3)))
constexpr int DM = 1024, SEQ = 16384, NSAMP = 512, MT = SEQ + NSAMP, INC = 3080, NPJ = 3072, PAST = 1024;
constexpr int NCHUNK = MT / 32;
constexpr float EPS = 1e-6f, LOG2E = 1.4426950408889634f;
constexpr float SC2 = 0.125f * LOG2E;
constexpr float THR2 = 40.0f * LOG2E;
constexpr size_t MiB = 1u << 20;
constexpr size_t WS_CTL = 0, CTL_BYTES = 1 * MiB;
constexpr size_t WS_WIN = 2 * MiB, WS_WOUT = 8 * MiB, WS_WP = 10 * MiB, WS_GT = 11 * MiB, WS_TP = 12 * MiB, WS_GC = 12 * MiB + 65536, WS_TC = 12 * MiB + 524288;
constexpr size_t WS_ADAP = 13 * MiB  , WS_ADAG = 15 * MiB  ;
constexpr size_t WS_XN = 16 * MiB, WS_PB = 50 * MiB, WS_Z = 150 * MiB, WS_VT = 184 * MiB  , WS_END = 202 * MiB;
constexpr int CW_ROWSS = 32768, CW_QKMAX = 49920, CW_KCMAX = 49984, CW_CNT = 50048, CW_PCNT = 51200  , CW_SIGA = 60032  , CW_SIGB = 60096  , CW_BAR = 65536  ;
constexpr int PB_Q = 0, PB_K = 512, PB_V = 1024, PB_AG = 1536, PB_U = 2048, PB_PG = 2560;
constexpr int LDS_BYTES = 148480, MISC_OFF = 147456;

struct Params {
    const float *x_prompt, *x_sample, *c_prompt, *c_sample, *cache_k, *cache_v, *cache_logf, *state_pool, *norm_g, *w_ada, *b_ada, *w_in, *b_f, *w_pool, *pool_scale, *w_out, *final_g;
    float* out; unsigned char* ws;
};
constexpr size_t O_YP = 0, O_YS = O_YP + (size_t)SEQ * DM, O_KP = O_YS + (size_t)NSAMP * DM, O_VP = O_KP + (size_t)SEQ * 512, O_LFP = O_VP + (size_t)SEQ * 512,
                 O_PP = O_LFP + (size_t)SEQ * 8, O_KS = O_PP + 15 * 512, O_VS = O_KS + (size_t)NSAMP * 512, O_LFS = O_VS + (size_t)NSAMP * 512, O_PS = O_LFS + (size_t)NSAMP * 8, O_END = O_PS + 8 * 15 * 512;

__device__ __forceinline__ unsigned f2bf(float f) { unsigned u = __builtin_bit_cast(unsigned, f); return (u + 0x7fffu + ((u >> 16) & 1u)) >> 16; }
__device__ __forceinline__ unsigned cvtpk(float lo, float hi) { typedef float f2 __attribute__((ext_vector_type(2))); typedef __bf16 b2 __attribute__((ext_vector_type(2))); f2 v = {lo, hi}; b2 b = __builtin_convertvector(v, b2); return __builtin_bit_cast(unsigned, b); }
__device__ __forceinline__ unsigned pk2(float lo, float hi) { return cvtpk(lo, hi); }
__device__ __forceinline__ float bf2f(unsigned short b) { return __uint_as_float(((unsigned)b) << 16); }
__device__ __forceinline__ float wave_sum(float v) {
#pragma unroll
    for (int o = 1; o < 64; o <<= 1) v += __shfl_xor(v, o);
    return v;
}
__device__ __forceinline__ float silu_f(float v) { return v * __builtin_amdgcn_rcpf(1.0f + __expf(-v)); }

__device__ __forceinline__ void tr_item(const float* W, int ldw, int k0, int c0, bf16* WT, int ldt, int n0, float* scr, int lane) {
#pragma unroll 8
    for (int i = 0; i < 32; ++i) { const int kk = 2 * i + (lane >> 5); scr[kk * 33 + (lane & 31)] = W[(size_t)(k0 + kk) * ldw + c0 + (lane & 31)]; }
    asm volatile("s_waitcnt lgkmcnt(0)" ::: "memory");
    const int c = lane & 7;
#pragma unroll
    for (int j = 0; j < 4; ++j) { const int n = (lane >> 3) + 8 * j; const float* s = scr + (8 * c) * 33 + n;
        u32x4 o; o.x = pk2(s[0 * 33], s[1 * 33]); o.y = pk2(s[2 * 33], s[3 * 33]); o.z = pk2(s[4 * 33], s[5 * 33]); o.w = pk2(s[6 * 33], s[7 * 33]);
        *(u32x4*)(WT + (size_t)(n0 + n) * ldt + k0 + 8 * c) = o; }
    asm volatile("s_waitcnt lgkmcnt(0)" ::: "memory");
}

struct AttnState { float m, l; f32x16 o0, o1; };

template <bool F32SRC, bool DIAG>
__device__ __forceinline__ void attn_tile(AttnState& st, const bf16x8 (&qr)[4], float gqb, const void* kb, const void* vb, const float* g2, int lane) {
    int r32 = lane & 31, h2 = lane >> 5;
    asm volatile("" : "+v"(r32), "+v"(h2));
    bf16x8 kf[4]; bf16x8 va[2][2]; f32x4 gk[4];
    if constexpr (!F32SRC) {
        const bf16* kp = (const bf16*)kb + (size_t)r32 * 3072 + 8 * h2;
#pragma unroll
        for (int d0 = 0; d0 < 4; ++d0) kf[d0] = *(const bf16x8*)(kp + 16 * d0);
#pragma unroll
        for (int i = 0; i < 4; ++i) gk[i] = *(const f32x4*)(g2 + 8 * i + 4 * h2);
        const bf16* vp = (const bf16*)vb + (size_t)r32 * MT + 4 * h2;
        u32x2 vr[2][2][2];
#pragma unroll
        for (int db = 0; db < 2; ++db)
#pragma unroll
            for (int s = 0; s < 2; ++s)
#pragma unroll
                for (int g = 0; g < 2; ++g) vr[db][s][g] = *(const u32x2*)(vp + (size_t)(32 * db) * MT + 16 * s + 8 * g);
        asm volatile("" ::: "memory");
#pragma unroll
        for (int db = 0; db < 2; ++db)
#pragma unroll
            for (int s = 0; s < 2; ++s) { u32x4 w; w.x = vr[db][s][0].x; w.y = vr[db][s][0].y; w.z = vr[db][s][1].x; w.w = vr[db][s][1].y; va[db][s] = __builtin_bit_cast(bf16x8, w); }
    } else {
        const float* kp = (const float*)kb + (size_t)r32 * 512 + 8 * h2;
        f32x4 kr[4][2];
#pragma unroll
        for (int d0 = 0; d0 < 4; ++d0) { kr[d0][0] = *(const f32x4*)(kp + 16 * d0); kr[d0][1] = *(const f32x4*)(kp + 16 * d0 + 4); }
#pragma unroll
        for (int i = 0; i < 4; ++i) gk[i] = *(const f32x4*)(g2 + 8 * i + 4 * h2);
        const float* vp = (const float*)vb + r32 + (size_t)(4 * h2) * 512;
        float vr[2][2][8];
#pragma unroll
        for (int db = 0; db < 2; ++db)
#pragma unroll
            for (int s = 0; s < 2; ++s)
#pragma unroll
                for (int j = 0; j < 8; ++j) vr[db][s][j] = vp[(size_t)(16 * s + 8 * (j >> 2) + (j & 3)) * 512 + 32 * db];
        asm volatile("" ::: "memory");
#pragma unroll
        for (int d0 = 0; d0 < 4; ++d0) { const f32x4 a = kr[d0][0], b = kr[d0][1];
            u32x4 w; w.x = cvtpk(a[0], a[1]); w.y = cvtpk(a[2], a[3]); w.z = cvtpk(b[0], b[1]); w.w = cvtpk(b[2], b[3]); kf[d0] = __builtin_bit_cast(bf16x8, w); }
#pragma unroll
        for (int db = 0; db < 2; ++db)
#pragma unroll
            for (int s = 0; s < 2; ++s) { u32x4 w;
#pragma unroll
                for (int jj = 0; jj < 4; ++jj) w[jj] = cvtpk(vr[db][s][2 * jj], vr[db][s][2 * jj + 1]);
                va[db][s] = __builtin_bit_cast(bf16x8, w); }
    }
    f32x16 S = {};
#pragma unroll
    for (int d0 = 0; d0 < 4; ++d0) S = __builtin_amdgcn_mfma_f32_32x32x16_bf16(kf[d0], qr[d0], S, 0, 0, 0);
    float mx = -INFINITY;
#pragma unroll
    for (int r = 0; r < 16; ++r) { float v = S[r] * SC2 + (gqb - gk[r >> 2][r & 3]);
        if (DIAG) { const int kvl = (r & 3) + 8 * (r >> 2) + 4 * h2; if (kvl > r32) v = -INFINITY; }
        S[r] = v; mx = fmaxf(mx, v); }
    mx = fmaxf(mx, __shfl_xor(mx, 32));
    const float mn = fmaxf(st.m, mx); const float alpha = __builtin_amdgcn_exp2f(st.m - mn); st.m = mn;
    float sum = 0.f;
#pragma unroll
    for (int r = 0; r < 16; ++r) { S[r] = __builtin_amdgcn_exp2f(S[r] - mn); sum += S[r]; }
    st.l = st.l * alpha + sum;
#pragma unroll
    for (int r = 0; r < 16; ++r) { st.o0[r] *= alpha; st.o1[r] *= alpha; }
    bf16x8 pb[2];
#pragma unroll
    for (int s = 0; s < 2; ++s) { u32x4 w; w.x = cvtpk(S[8 * s + 0], S[8 * s + 1]); w.y = cvtpk(S[8 * s + 2], S[8 * s + 3]); w.z = cvtpk(S[8 * s + 4], S[8 * s + 5]); w.w = cvtpk(S[8 * s + 6], S[8 * s + 7]); pb[s] = __builtin_bit_cast(bf16x8, w); }
    st.o0 = __builtin_amdgcn_mfma_f32_32x32x16_bf16(va[0][0], pb[0], st.o0, 0, 0, 0); st.o0 = __builtin_amdgcn_mfma_f32_32x32x16_bf16(va[0][1], pb[1], st.o0, 0, 0, 0);
    st.o1 = __builtin_amdgcn_mfma_f32_32x32x16_bf16(va[1][0], pb[0], st.o1, 0, 0, 0); st.o1 = __builtin_amdgcn_mfma_f32_32x32x16_bf16(va[1][1], pb[1], st.o1, 0, 0, 0);
}
struct TileRegs { bf16x8 kf[4]; u32x2 vr[2][2][2]; f32x4 gk[4]; };
__device__ __forceinline__ void tile_load(TileRegs& T, const bf16* kb, const bf16* vb, const float* g2, int lane) {
    int r32 = lane & 31, h2 = lane >> 5;
    asm volatile("" : "+v"(r32), "+v"(h2));
    const bf16* kp = kb + (size_t)r32 * 3072 + 8 * h2;
#pragma unroll
    for (int d0 = 0; d0 < 4; ++d0) T.kf[d0] = *(const bf16x8*)(kp + 16 * d0);
#pragma unroll
    for (int i = 0; i < 4; ++i) T.gk[i] = *(const f32x4*)(g2 + 8 * i + 4 * h2);
    const bf16* vp = vb + (size_t)r32 * MT + 4 * h2;
#pragma unroll
    for (int db = 0; db < 2; ++db)
#pragma unroll
        for (int s = 0; s < 2; ++s)
#pragma unroll
            for (int g = 0; g < 2; ++g) T.vr[db][s][g] = *(const u32x2*)(vp + (size_t)(32 * db) * MT + 16 * s + 8 * g);
}
template <bool DIAG>
__device__ __forceinline__ void tile_compute(AttnState& st, const bf16x8* qls, float gqb, const TileRegs& T, int lane) {
    const int r32 = lane & 31, h2 = lane >> 5;
    bf16x8 qr[4];
#pragma unroll
    for (int d0 = 0; d0 < 4; ++d0) qr[d0] = qls[d0 * 64 + lane];
    f32x16 S = {};
#pragma unroll
    for (int d0 = 0; d0 < 4; ++d0) S = __builtin_amdgcn_mfma_f32_32x32x16_bf16(T.kf[d0], qr[d0], S, 0, 0, 0);
    float mx = -INFINITY;
#pragma unroll
    for (int r = 0; r < 16; ++r) { float v = S[r] * SC2 + (gqb - T.gk[r >> 2][r & 3]);
        if (DIAG) { const int kvl = (r & 3) + 8 * (r >> 2) + 4 * h2; if (kvl > r32) v = -INFINITY; }
        S[r] = v; mx = fmaxf(mx, v); }
    mx = fmaxf(mx, __shfl_xor(mx, 32));
    const float mn = fmaxf(st.m, mx); const float alpha = __builtin_amdgcn_exp2f(st.m - mn); st.m = mn;
    float sum = 0.f;
#pragma unroll
    for (int r = 0; r < 16; ++r) { S[r] = __builtin_amdgcn_exp2f(S[r] - mn); sum += S[r]; }
    st.l = st.l * alpha + sum;
#pragma unroll
    for (int r = 0; r < 16; ++r) { st.o0[r] *= alpha; st.o1[r] *= alpha; }
    bf16x8 pb[2];
#pragma unroll
    for (int s = 0; s < 2; ++s) { u32x4 w; w.x = cvtpk(S[8 * s + 0], S[8 * s + 1]); w.y = cvtpk(S[8 * s + 2], S[8 * s + 3]); w.z = cvtpk(S[8 * s + 4], S[8 * s + 5]); w.w = cvtpk(S[8 * s + 6], S[8 * s + 7]); pb[s] = __builtin_bit_cast(bf16x8, w); }
    bf16x8 va[2][2];
#pragma unroll
    for (int db = 0; db < 2; ++db)
#pragma unroll
        for (int s = 0; s < 2; ++s) { u32x4 w; w.x = T.vr[db][s][0].x; w.y = T.vr[db][s][0].y; w.z = T.vr[db][s][1].x; w.w = T.vr[db][s][1].y; va[db][s] = __builtin_bit_cast(bf16x8, w); }
    st.o0 = __builtin_amdgcn_mfma_f32_32x32x16_bf16(va[0][0], pb[0], st.o0, 0, 0, 0); st.o0 = __builtin_amdgcn_mfma_f32_32x32x16_bf16(va[0][1], pb[1], st.o0, 0, 0, 0);
    st.o1 = __builtin_amdgcn_mfma_f32_32x32x16_bf16(va[1][0], pb[0], st.o1, 0, 0, 0); st.o1 = __builtin_amdgcn_mfma_f32_32x32x16_bf16(va[1][1], pb[1], st.o1, 0, 0, 0);
}
__device__ __forceinline__ void attn_finish(const AttnState& st, float ltot, const bf16* PB, bf16* Z, int q0, int hd, int lane) {
    const int r32 = lane & 31, h2 = lane >> 5; const float inv = 1.0f / ltot;
    const bf16* agp = PB + (size_t)(q0 + r32) * 3072 + PB_AG + hd * 64 + 4 * h2; bf16* zp = Z + (size_t)(q0 + r32) * 1024 + hd * 64 + 4 * h2;
    u32x2 av[2][4];
#pragma unroll
    for (int db = 0; db < 2; ++db)
#pragma unroll
        for (int i = 0; i < 4; ++i) av[db][i] = *(const u32x2*)(agp + 32 * db + 8 * i);
#pragma unroll
    for (int db = 0; db < 2; ++db)
#pragma unroll
        for (int i = 0; i < 4; ++i) { const u32x2 a = av[db][i];
            const float a0 = __uint_as_float(a.x << 16), a1 = __uint_as_float(a.x & 0xffff0000u), a2 = __uint_as_float(a.y << 16), a3 = __uint_as_float(a.y & 0xffff0000u);
            const f32x16& o = db ? st.o1 : st.o0;
            u32x2 w; w.x = cvtpk(o[4 * i + 0] * inv * silu_f(a0), o[4 * i + 1] * inv * silu_f(a1)); w.y = cvtpk(o[4 * i + 2] * inv * silu_f(a2), o[4 * i + 3] * inv * silu_f(a3));
            *(u32x2*)(zp + 32 * db + 8 * i) = w; }
}
__device__ __forceinline__ void load_q(bf16x8 (&qr)[4], const bf16* PB, int q0, int hd, int lane) {
    const bf16* qp = PB + (size_t)(q0 + (lane & 31)) * 3072 + PB_Q + hd * 64 + 8 * (lane >> 5);
#pragma unroll
    for (int d0 = 0; d0 < 4; ++d0) qr[d0] = *(const bf16x8*)(qp + 16 * d0);
}

#define GAS __attribute__((address_space(1)))
#define RLX_AGENT __ATOMIC_RELAXED, __HIP_MEMORY_SCOPE_AGENT
#define XB_TMO      128
#define XB_XCNT(j)  (256  + 64 * (j))
#define XB_XSUB(j)  (1280 + 64 * (j))
#define XB_XGEN(j)  (2304 + 64 * (j))
#define XB_TOP      3328
#define XB_TOPGEN   3392
#define XCD_BAR_WORDS 3456
#define XB_SPIN_CAP (1u << 18)

__device__ __forceinline__ unsigned xb_ld(unsigned* p)              { return __hip_atomic_load(p, __ATOMIC_RELAXED, __HIP_MEMORY_SCOPE_AGENT); }
__device__ __forceinline__ unsigned xb_add(unsigned* p, unsigned v) { return __hip_atomic_fetch_add(p, v, __ATOMIC_RELAXED, __HIP_MEMORY_SCOPE_AGENT); }
__device__ __forceinline__ unsigned xb_xcc_id() { return (unsigned)__builtin_amdgcn_s_getreg((3 << 11) | 20) & 0xFu; }
#define XB_SPIN(cond, bar) do { unsigned _sp = 0; while (cond) { __builtin_amdgcn_s_sleep(1); \
    if ((++_sp & 255u) == 0u) { if (xb_ld(&(bar)[XB_TMO])) break; if (_sp > XB_SPIN_CAP) { atomicAdd(&(bar)[XB_TMO], 1u); break; } } } } while (0)

struct XcdBarrier {
    unsigned* bar; unsigned x;
    volatile LAS unsigned* st;
};

__device__ __forceinline__ XcdBarrier xcd_barrier_post(unsigned* bar, volatile LAS unsigned* st) {
    XcdBarrier b; b.bar = bar; b.x = xb_xcc_id(); b.st = st;
    if (threadIdx.x == 0) (void)xb_add(&bar[XB_XCNT(b.x)], 1u);
    return b;
}
__device__ __forceinline__ void xcd_barrier_complete(unsigned* bar, unsigned x, unsigned& nloc, unsigned& nx) {
    const unsigned G = gridDim.x * gridDim.y * gridDim.z;
    unsigned sum, cnt, mine, sp = 0u;
    for (;;) {
        sum = 0u; cnt = 0u; mine = 0u;
#pragma unroll
        for (unsigned j = 0; j < 16; ++j) { const unsigned c = xb_ld(&bar[XB_XCNT(j)]); sum += c; cnt += (c > 0u) ? 1u : 0u; mine = (j == x) ? c : mine; }
        if (sum == G) break;
        __builtin_amdgcn_s_sleep(1);
        if ((++sp & 255u) == 0u) { if (xb_ld(&bar[XB_TMO])) break; if (sp > XB_SPIN_CAP) { atomicAdd(&bar[XB_TMO], 1u); break; } }
    }
    nloc = mine > 0u ? mine : 1u; nx = cnt > 0u ? cnt : 1u;
}

__device__ __forceinline__ void xcd_barrier(const XcdBarrier& b) {
    asm volatile("s_waitcnt vmcnt(0)" ::: "memory");
    __syncthreads();
    if (threadIdx.x == 0) {
        unsigned* bar = b.bar;
        __builtin_amdgcn_s_waitcnt(0);
        unsigned nloc = b.st[0], nx = b.st[1];
        if (nloc == 0u) { xcd_barrier_complete(bar, b.x, nloc, nx); b.st[0] = nloc; b.st[1] = nx; }
        const unsigned old = xb_add(&bar[XB_XSUB(b.x)], 1u);
        const unsigned gen = old / nloc;
        if (old + 1u == (gen + 1u) * nloc) {
            __builtin_amdgcn_fence(__ATOMIC_RELEASE, "agent");
            asm volatile("s_waitcnt vmcnt(0)" ::: "memory");
            const unsigned og = xb_add(&bar[XB_TOP], 1u);
            const unsigned tg = og / nx;
            if (og + 1u == (tg + 1u) * nx) xb_add(&bar[XB_TOPGEN], 1u);
            else XB_SPIN(xb_ld(&bar[XB_TOPGEN]) == tg, bar);
            __builtin_amdgcn_fence(__ATOMIC_ACQUIRE, "agent");
            xb_add(&bar[XB_XGEN(b.x)], 1u);
            asm volatile("s_waitcnt vmcnt(0)" ::: "memory");
        } else {
            XB_SPIN(xb_ld(&bar[XB_XGEN(b.x)]) == gen, bar);
            __builtin_amdgcn_fence(__ATOMIC_ACQUIRE, "agent");
            asm volatile("s_waitcnt vmcnt(0)" ::: "memory");
        }
    }
    __syncthreads();
}

__global__ void __launch_bounds__(512, 2) fox_pool_fwd(Params P) {
    extern __shared__ __attribute__((aligned(16))) unsigned char lds[];
    const int tid = threadIdx.x, lane = tid & 63, wave = __builtin_amdgcn_readfirstlane(tid >> 6), G = gridDim.x, bid = blockIdx.x;
    unsigned char* ws = P.ws;
    float* ctlf = (float*)(ws + WS_CTL); unsigned* ctlu = (unsigned*)(ws + WS_CTL);
    float* adaP = (float*)(ws + WS_ADAP); float* adaG = (float*)(ws + WS_ADAG); float* rowss = ctlf + CW_ROWSS; unsigned* pcnt = ctlu + CW_PCNT; unsigned* qkmax = ctlu + CW_QKMAX; unsigned* kcmax = ctlu + CW_KCMAX; unsigned* cnt = ctlu + CW_CNT;
    bf16* WIN = (bf16*)(ws + WS_WIN); bf16* WOUT = (bf16*)(ws + WS_WOUT); bf16* WP = (bf16*)(ws + WS_WP);
    float* GT2 = (float*)(ws + WS_GT); float* TP2 = (float*)(ws + WS_TP); float* GC2 = (float*)(ws + WS_GC); float* TC2 = (float*)(ws + WS_TC);
    bf16* XN = (bf16*)(ws + WS_XN); bf16* PB = (bf16*)(ws + WS_PB); bf16* Z = (bf16*)(ws + WS_Z); bf16* VT = (bf16*)(ws + WS_VT);
    float* ldsf = (float*)lds;
    volatile LAS unsigned* MISC = (volatile LAS unsigned*)((LAS unsigned char*)lds + MISC_OFF);
    if (tid < 16) MISC[tid] = 0u;
    __syncthreads();
    const XcdBarrier bar = xcd_barrier_post(ctlu + CW_BAR, MISC);
    unsigned long long tp0 = 0, tp1 = 0; if (TPROBE) tp0 = __builtin_amdgcn_s_memrealtime();
#define TP(k) do { if (TPROBE == (k)) tp1 = __builtin_amdgcn_s_memrealtime(); } while (0)

    for (int task_ = bid; task_ < 192 * REP_P0; task_ += G) { const int task = task_ % 192;
        const int cb = task % 12, kc = task / 12, k0 = kc * 64, n0 = cb * 256;
        float* Ssh = ldsf; float* part = ldsf + 1024;
        for (int i = tid; i < 576; i += 512) { const int b = i >> 6, kk = i & 63; const float c = (b == 0) ? P.c_prompt[k0 + kk] : P.c_sample[(b - 1) * 1024 + k0 + kk]; Ssh[i] = silu_f(c); }
        __syncthreads();
        f32x4 acc[9];
#pragma unroll
        for (int b = 0; b < 9; ++b) acc[b] = (f32x4){0.f, 0.f, 0.f, 0.f};
#pragma unroll
        for (int r = 0; r < 8; ++r) { const int k = wave * 8 + r; const f32x4 w = *(const f32x4*)(P.w_ada + (size_t)(k0 + k) * 3072 + n0 + 4 * lane);
#pragma unroll
            for (int b = 0; b < 9; ++b) acc[b] += Ssh[b * 64 + k] * w; }
#pragma unroll
        for (int b = 0; b < 9; ++b) *(f32x4*)(part + (wave * 9 + b) * 256 + 4 * lane) = acc[b];
        __syncthreads();
        for (int i = tid; i < 2304; i += 512) { const int b = i >> 8, n = i & 255; float s = 0.f;
#pragma unroll
            for (int w = 0; w < 8; ++w) s += part[(w * 9 + b) * 256 + n];
            adaP[(size_t)(kc * 9 + b) * 3072 + n0 + n] = s; }
        __syncthreads();
    }
    xcd_barrier(bar);
    TP(1);

    {
        float* wfs = ldsf;
        float* lfs = ldsf + 8192;
        float* AB0 = ldsf + 9216;
        float* AB1 = ldsf + 11264;
        { float wv[16];
#pragma unroll
            for (int q = 0; q < 16; ++q) { const int i = tid + 512 * q, k = i >> 3, e = i & 7; wv[q] = P.w_in[(size_t)k * INC + 2048 + e]; }
#pragma unroll
            for (int q = 0; q < 16; ++q) { const int i = tid + 512 * q, k = i >> 3, e = i & 7; wfs[((((k >> 8) * 4 + (k & 3)) * 2 + (e >> 2)) * 64 + ((k >> 2) & 63)) * 4 + (e & 3)] = wv[q]; } }
        if (tid < 256) { const int col = 4 * tid; f32x4 sh = *(const f32x4*)(P.b_ada + col), sc = *(const f32x4*)(P.b_ada + 1024 + col);
#pragma unroll
            for (int kc = 0; kc < 16; ++kc) { sh += *(const f32x4*)(adaP + (size_t)(kc * 9) * 3072 + col); sc += *(const f32x4*)(adaP + (size_t)(kc * 9) * 3072 + 1024 + col); }
            *(f32x4*)(AB0 + col) = *(const f32x4*)(P.norm_g + col) * (1.0f + sc); *(f32x4*)(AB0 + 1024 + col) = sh; }
        else if (bid < 9) { const int col = 4 * (tid - 256); f32x4 gt = *(const f32x4*)(P.b_ada + 2048 + col);
#pragma unroll
            for (int kc = 0; kc < 16; ++kc) gt += *(const f32x4*)(adaP + (size_t)(kc * 9 + bid) * 3072 + 2048 + col);
            *(f32x4*)(adaG + bid * 1024 + col) = gt; }
        __syncthreads();
        for (int kk = 0; kk < 4; ++kk) {
            const int unit = kk < 3 ? bid + 256 * kk : ((bid >= 16 && bid < 32) ? 752 + bid : -1);
            if (unit < 0 || unit >= NCHUNK + 256) continue;
            if (unit < NCHUNK) {
                const int m0 = unit * 32; const bool pr = m0 < SEQ; const float* AB = AB0;
                if (!pr) { const int bi = 1 + ((m0 - SEQ) >> 6);
                    if (tid < 256) { const int col = 4 * tid; f32x4 sh = *(const f32x4*)(P.b_ada + col), sc = *(const f32x4*)(P.b_ada + 1024 + col);
#pragma unroll
                        for (int kc = 0; kc < 16; ++kc) { sh += *(const f32x4*)(adaP + (size_t)(kc * 9 + bi) * 3072 + col); sc += *(const f32x4*)(adaP + (size_t)(kc * 9 + bi) * 3072 + 1024 + col); }
                        *(f32x4*)(AB1 + col) = *(const f32x4*)(P.norm_g + col) * (1.0f + sc); *(f32x4*)(AB1 + 1024 + col) = sh; }
                    __syncthreads(); AB = AB1; }
                f32x4 xv[4][4];
#pragma unroll
                for (int r = 0; r < 4; ++r) { const int m = m0 + wave * 4 + r; const float* xrow = pr ? P.x_prompt + (size_t)m * DM : P.x_sample + (size_t)(m - SEQ) * DM;
#pragma unroll
                    for (int j = 0; j < 4; ++j) xv[r][j] = *(const f32x4*)(xrow + 4 * lane + 256 * j); }
                float lfv[4];
#pragma unroll
                for (int r = 0; r < 4; ++r) {
                    const int m = m0 + wave * 4 + r;
                    float ss = 0.f;
#pragma unroll
                    for (int j = 0; j < 4; ++j) { const f32x4 v = xv[r][j]; ss += (v[0] * v[0] + v[1] * v[1]) + (v[2] * v[2] + v[3] * v[3]); }
                    const float rs = 1.0f / sqrtf(wave_sum(ss) * (1.0f / DM) + EPS);
                    float f[8];
#pragma unroll
                    for (int e = 0; e < 8; ++e) f[e] = 0.f;
#pragma unroll
                    for (int j = 0; j < 4; ++j) { const int col = 4 * lane + 256 * j;
                        const f32x4 hv = (xv[r][j] * rs) * *(const f32x4*)(AB + col) + *(const f32x4*)(AB + 1024 + col);
                        u32x2 w; w.x = pk2(hv[0], hv[1]); w.y = pk2(hv[2], hv[3]); *(u32x2*)(XN + (size_t)m * DM + col) = w;
#pragma unroll
                        for (int i = 0; i < 4; ++i) { const f32x4 w0 = *(const f32x4*)(wfs + (((j * 4 + i) * 2 + 0) * 64 + lane) * 4), w1 = *(const f32x4*)(wfs + (((j * 4 + i) * 2 + 1) * 64 + lane) * 4);
                            f[0] += hv[i] * w0[0]; f[1] += hv[i] * w0[1]; f[2] += hv[i] * w0[2]; f[3] += hv[i] * w0[3]; f[4] += hv[i] * w1[0]; f[5] += hv[i] * w1[1]; f[6] += hv[i] * w1[2]; f[7] += hv[i] * w1[3]; } }
                    { const bool b5 = (lane & 32) != 0, b4 = (lane & 16) != 0, b3 = (lane & 8) != 0; float g4[4], g2[2], g1;
#pragma unroll
                        for (int e = 0; e < 4; ++e) { const float keep = b5 ? f[e + 4] : f[e], send = b5 ? f[e] : f[e + 4]; g4[e] = keep + __shfl_xor(send, 32); }
#pragma unroll
                        for (int e = 0; e < 2; ++e) { const float keep = b4 ? g4[e + 2] : g4[e], send = b4 ? g4[e] : g4[e + 2]; g2[e] = keep + __shfl_xor(send, 16); }
                        { const float keep = b3 ? g2[1] : g2[0], send = b3 ? g2[0] : g2[1]; g1 = keep + __shfl_xor(send, 8); }
                        g1 += __shfl_xor(g1, 4); g1 += __shfl_xor(g1, 2); g1 += __shfl_xor(g1, 1);
                        lfv[r] = g1; }
                }
                if ((lane & 7) == 0) { const int e = lane >> 3; const float bfv = P.b_f[e];
#pragma unroll
                    for (int r = 0; r < 4; ++r) { const int m = m0 + wave * 4 + r; const float z = lfv[r] + bfv; const float lf = fminf(z, 0.f) - log1pf(__expf(-fabsf(z)));
                        lfs[(wave * 4 + r) * 8 + e] = lf;
                        if (pr) P.out[O_LFP + (size_t)m * 8 + e] = lf; else P.out[O_LFS + (size_t)(m - SEQ) * 8 + e] = lf; } }
                __syncthreads();
                if (tid < 8) { float a = 0.f; for (int r = 0; r < 32; ++r) { a += lfs[r * 8 + tid]; GT2[(size_t)tid * MT + m0 + r] = a * LOG2E; } TP2[unit * 8 + tid] = a * LOG2E; }
                __syncthreads();
            } else {
                const int cu = unit - NCHUNK, b = cu >> 5, s0 = (cu & 31) * 32;
                if (tid < 8) { float lv[32];
#pragma unroll
                    for (int r = 0; r < 32; ++r) lv[r] = P.cache_logf[(size_t)(b * PAST + s0 + r) * 8 + tid];
                    float a = 0.f;
#pragma unroll
                    for (int r = 0; r < 32; ++r) { a += lv[r]; GC2[(size_t)(b * 8 + tid) * PAST + s0 + r] = a * LOG2E; } TC2[cu * 8 + tid] = a * LOG2E; }
                float mx = 0.f; f32x4 ka[4], kc4[4];
#pragma unroll
                for (int r = 0; r < 4; ++r) { const float* kp = P.cache_k + (size_t)(b * PAST + s0 + wave * 4 + r) * 512 + 8 * lane; ka[r] = *(const f32x4*)kp; kc4[r] = *(const f32x4*)(kp + 4); }
#pragma unroll
                for (int r = 0; r < 4; ++r) { const f32x4 a = ka[r], c = kc4[r];
                    float s = (a[0] * a[0] + a[1] * a[1]) + (a[2] * a[2] + a[3] * a[3]) + (c[0] * c[0] + c[1] * c[1]) + (c[2] * c[2] + c[3] * c[3]);
                    s += __shfl_xor(s, 1); s += __shfl_xor(s, 2); s += __shfl_xor(s, 4); mx = fmaxf(mx, s); }
                if ((lane & 7) == 0) atomicMax(kcmax + (lane >> 3), __float_as_uint(mx));
            }
        }
        __syncthreads();
        if (bid >= 16) {
            float* scr = ldsf + wave * 4096;
            const int gw = (bid - 16) * 8 + wave, NGW = (G - 16) * 8;
            for (int it = gw; it < 2080; it += NGW) {
                if (it < 1536) { const int kb = it / 96, nb = it % 96, n0 = 32 * nb; tr_item(P.w_in, INC, 64 * kb, n0 < 2048 ? n0 : n0 + 8, WIN, 1024, n0, scr, lane); }
                else if (it < 2048) { const int r = it - 1536, kb = r / 32, nb = r % 32; tr_item(P.w_out, 1024, 64 * kb, 32 * nb, WOUT, 1024, 32 * nb, scr, lane); }
                else { const int r = it - 2048, g = r >> 3, kb = (r >> 2) & 1, nb = r & 3; tr_item(P.w_pool + (size_t)g * 128 * 128, 128, 64 * kb, 32 * nb, WP + (size_t)g * 128 * 128, 128, 32 * nb, scr, lane); }
            }
        }
    }
    xcd_barrier(bar);
    TP(2);

    {
        pg8::Gemm g{XN, WIN, MT, NPJ, DM}; pg8::StaticOrder S; S.init(SEQ, NPJ, G, bid); S.rep = REP_P2;
        pg8::EpiProj E{PB, P.out, qkmax, VT, (LAS unsigned char*)lds + 131072};
        static_assert(O_KP == 17301504 && O_KS == 34217472 && O_VP == 25690112 && O_VS == 34479616, "d_out map");
        pg8::gemm_phase<pg8::EpiProj, pg8::StaticOrder, true, true>((LAS unsigned char*)lds, g, S, E);
    }
    xcd_barrier(bar);
    TP(3);

    if (G == 256) {
        const int r32 = lane & 31, h2 = lane >> 5;
        unsigned* sigA = ctlu + CW_SIGA;
        unsigned* sigB = ctlu + CW_SIGB;
#define SIGNAL(sig) do { asm volatile("s_waitcnt vmcnt(0)" ::: "memory"); __syncthreads(); if (tid == 0) { __builtin_amdgcn_fence(__ATOMIC_RELEASE, "agent"); asm volatile("s_waitcnt vmcnt(0)" ::: "memory"); (void)__hip_atomic_fetch_add(sig, 1u, __ATOMIC_RELAXED, __HIP_MEMORY_SCOPE_AGENT); } } while (0)
#define WAITSIG(sig, n) do { if (tid == 0) { unsigned sp_ = 0; while (__hip_atomic_load(sig, __ATOMIC_RELAXED, __HIP_MEMORY_SCOPE_AGENT) < (n)) { __builtin_amdgcn_s_sleep(8); if (++sp_ > (1u << 20)) break; } __builtin_amdgcn_fence(__ATOMIC_ACQUIRE, "agent"); asm volatile("s_waitcnt vmcnt(0)" ::: "memory"); } __syncthreads(); } while (0)
        if (bid >= 232) {
            const int k = bid - 232;
            pg8::Gemm g{XN, WIN, MT, NPJ, DM}; pg8::OneUnit S{64 + k / 12, k % 12};
            pg8::EpiProj E{PB, P.out, qkmax, VT, (LAS unsigned char*)lds + 131072};
            pg8::gemm_phase<pg8::EpiProj, pg8::OneUnit, true, true>((LAS unsigned char*)lds, g, S, E);
            { unsigned* sg = ctlu + CW_SIGB + 64 + 64 * ((k / 12) * 2 + ((k % 12) >= 8 ? 1 : 0)); SIGNAL(sg); }
        }
        const int gwv = bid * 8 + wave;
        unsigned ulist[3]; int nun = 0;
#pragma unroll
        for (int k = 0; k < 3; ++k) { unsigned u = 0xffffffffu; const int xcd = bid & 7;
            if (bid < 64) { if (k == 0) u = (unsigned)((xcd * 8 + (bid >> 3)) * 8 + wave); }
            else if (bid < 72) { }
            else if (bid < 80) { if (k == 0) u = (unsigned)((64 + (bid - 72)) * 8 + wave); }
            else if (bid >= 232) { if (k == 0) u = (unsigned)((72 + xcd * 3 + ((bid - 232) >> 3)) * 8 + wave); }
            else { const int vn = xcd * 19 + ((bid - 80) >> 3); const int nch = vn < 112 ? 3 : 2, c0 = vn < 112 ? 96 + 3 * vn : 432 + 2 * (vn - 112); if (k < nch) u = (unsigned)((c0 + k) * 8 + wave); }
            ulist[k] = u; if (u != 0xffffffffu) nun = k + 1; }
#pragma unroll 1
        for (int pi = 0; pi < 2; ++pi) {
            const unsigned ua = pi == 0 ? ulist[0] : ulist[2]; const unsigned ub = pi == 0 ? ulist[1] : 0xffffffffu;
            if (ua == 0xffffffffu) break;
            const bool hasb = ub != 0xffffffffu;
            const int cqa = (int)(ua >> 3), hda = (int)(ua & 7), q0a = cqa * 32;
            const int cqb = hasb ? (int)(ub >> 3) : cqa, hdb = hasb ? (int)(ub & 7) : hda, q0b = cqb * 32;
            const float qkba = 2.0f * 1.02f * SC2 * sqrtf((__uint_as_float(qkmax[2 * hda]) + __uint_as_float(qkmax[2 * hda + 1])) * (__uint_as_float(qkmax[16 + 2 * hda]) + __uint_as_float(qkmax[16 + 2 * hda + 1])));
            const float qkbb = 2.0f * 1.02f * SC2 * sqrtf((__uint_as_float(qkmax[2 * hdb]) + __uint_as_float(qkmax[2 * hdb + 1])) * (__uint_as_float(qkmax[16 + 2 * hdb]) + __uint_as_float(qkmax[16 + 2 * hdb + 1])));
            bf16x8* qla = (bf16x8*)(lds + wave * 8192); bf16x8* qlb = qla + 256;
            const float gqa = GT2[(size_t)hda * MT + q0a + r32], gqb_ = GT2[(size_t)hdb * MT + q0b + r32];
            AttnState sa, sb; sa.m = -INFINITY; sa.l = 0.f; sa.o0 = f32x16{}; sa.o1 = f32x16{}; sb.m = -INFINITY; sb.l = 0.f; sb.o0 = f32x16{}; sb.o1 = f32x16{};
            TileRegs TA, TB;
            tile_load(TA, PB + (size_t)q0a * 3072 + PB_K + hda * 64, VT + (size_t)(hda * 64) * MT + q0a, GT2 + (size_t)hda * MT + q0a, lane);
            if (hasb) tile_load(TB, PB + (size_t)q0b * 3072 + PB_K + hdb * 64, VT + (size_t)(hdb * 64) * MT + q0b, GT2 + (size_t)hdb * MT + q0b, lane);
            { bf16x8 qt[4]; load_q(qt, PB, q0a, hda, lane);
#pragma unroll
                for (int d0 = 0; d0 < 4; ++d0) qla[d0 * 64 + lane] = qt[d0];
                load_q(qt, PB, q0b, hdb, lane);
#pragma unroll
                for (int d0 = 0; d0 < 4; ++d0) qlb[d0 * 64 + lane] = qt[d0]; }
            asm volatile("" ::: "memory");
            tile_compute<true>(sa, qla, gqa, TA, lane);
            if (hasb) tile_compute<true>(sb, qlb, gqb_, TB, lane);
            int cka = cqa - 1, ckb = hasb ? cqb - 1 : -1; float basea = 0.f, baseb = 0.f;
            float tva = 0.f, tvb = 0.f; { const int ca = cka - lane, cb = ckb - lane; if (ca >= 0) tva = TP2[ca * 8 + hda]; if (cb >= 0) tvb = TP2[cb * 8 + hdb]; }
            int ia = 0, ib = 0;
            for (;;) {
                const bool ma = cka >= 0 && !(basea + qkba < -THR2), mb = ckb >= 0 && !(baseb + qkbb < -THR2);
                if (!ma && !mb) break;
                if (ma) { basea += __uint_as_float(__builtin_amdgcn_readlane(__float_as_uint(tva), ia & 63)); ++ia;
                    if ((ia & 63) == 0) { const int ca = cka - 1 - lane; tva = ca >= 0 ? TP2[ca * 8 + hda] : 0.f; }
                    tile_load(TA, PB + (size_t)cka * 32 * 3072 + PB_K + hda * 64, VT + (size_t)(hda * 64) * MT + cka * 32, GT2 + (size_t)hda * MT + cka * 32, lane); }
                if (mb) { baseb += __uint_as_float(__builtin_amdgcn_readlane(__float_as_uint(tvb), ib & 63)); ++ib;
                    if ((ib & 63) == 0) { const int cb = ckb - 1 - lane; tvb = cb >= 0 ? TP2[cb * 8 + hdb] : 0.f; }
                    tile_load(TB, PB + (size_t)ckb * 32 * 3072 + PB_K + hdb * 64, VT + (size_t)(hdb * 64) * MT + ckb * 32, GT2 + (size_t)hdb * MT + ckb * 32, lane); }
                asm volatile("" ::: "memory");
                if (ma) { tile_compute<false>(sa, qla, gqa + basea, TA, lane); --cka; } else cka = -1;
                if (mb) { tile_compute<false>(sb, qlb, gqb_ + baseb, TB, lane); --ckb; } else ckb = -1;
            }
            attn_finish(sa, sa.l + __shfl_xor(sa.l, 32), PB, Z, q0a, hda, lane);
            if (hasb) attn_finish(sb, sb.l + __shfl_xor(sb.l, 32), PB, Z, q0b, hdb, lane);
        }
        (void)nun;
        __syncthreads();
        if (bid < 72) { const int pmx = bid < 64 ? (bid >> 5) : ((bid - 64) >> 2); unsigned* sg = ctlu + CW_SIGB + 64 + 64 * (pmx * 2 + (bid < 64 ? 0 : 1)); const unsigned need = bid < 64 ? 8u : 4u; WAITSIG(sg, need); }
        if (bid < 64) {
            const int b = bid >> 3, hd = bid & 7, qc = wave & 1, sp = wave >> 1;
            const int q0 = SEQ + b * 64 + 32 * qc;
            const float qm2 = __uint_as_float(qkmax[2 * hd]) + __uint_as_float(qkmax[2 * hd + 1]);
            const float km2 = fmaxf(__uint_as_float(qkmax[16 + 2 * hd]) + __uint_as_float(qkmax[16 + 2 * hd + 1]), __uint_as_float(kcmax[hd]));
            const float qkb2 = 2.0f * 1.02f * SC2 * sqrtf(qm2 * km2);
            bf16x8 qr[4]; load_q(qr, PB, q0, hd, lane);
            const float gq = GT2[(size_t)hd * MT + q0 + r32];
            AttnState st; st.m = -INFINITY; st.l = 0.f; st.o0 = f32x16{}; st.o1 = f32x16{};
            float base = 0.f; int i = 1;
            if (sp == 0) attn_tile<false, true>(st, qr, gq, PB + (size_t)q0 * 3072 + PB_K + hd * 64, VT + (size_t)(hd * 64) * MT + q0, GT2 + (size_t)hd * MT + q0, lane);
            if (qc == 1) { base += TP2[(512 + 2 * b) * 8 + hd];
                if (sp == 1) attn_tile<false, false>(st, qr, gq + base, PB + (size_t)(q0 - 32) * 3072 + PB_K + hd * 64, VT + (size_t)(hd * 64) * MT + q0 - 32, GT2 + (size_t)hd * MT + q0 - 32, lane);
                i = 2; }
            const float tvc = (lane < 32) ? TC2[(b * 32 + 31 - lane) * 8 + hd] : 0.f;
            for (int c = 31; c >= 0; --c, ++i) {
                if (base + qkb2 < -THR2) break;
                base += __uint_as_float(__builtin_amdgcn_readlane(__float_as_uint(tvc), 31 - c));
                if ((i & 3) == sp) attn_tile<true, false>(st, qr, gq + base, P.cache_k + ((size_t)(b * PAST + c * 32) * 8 + hd) * 64, P.cache_v + ((size_t)(b * PAST + c * 32) * 8 + hd) * 64, GC2 + (size_t)(b * 8 + hd) * PAST + c * 32, lane);
            }
            float lt = st.l + __shfl_xor(st.l, 32);
            float* mine = ldsf + wave * (34 * 64);
            mine[lane] = st.m; mine[64 + lane] = lt;
#pragma unroll
            for (int r = 0; r < 16; ++r) { mine[(2 + r) * 64 + lane] = st.o0[r]; mine[(18 + r) * 64 + lane] = st.o1[r]; }
            __syncthreads();
            if (sp == 0) {
                float mt = st.m;
#pragma unroll
                for (int s = 1; s < 4; ++s) mt = fmaxf(mt, ldsf[(wave + 2 * s) * (34 * 64) + lane]);
                const float a0 = __builtin_amdgcn_exp2f(st.m - mt);
                lt *= a0;
#pragma unroll
                for (int r = 0; r < 16; ++r) { st.o0[r] *= a0; st.o1[r] *= a0; }
#pragma unroll
                for (int s = 1; s < 4; ++s) { const float* oth = ldsf + (wave + 2 * s) * (34 * 64); const float as = __builtin_amdgcn_exp2f(oth[lane] - mt);
                    lt += as * oth[64 + lane];
#pragma unroll
                    for (int r = 0; r < 16; ++r) { st.o0[r] += as * oth[(2 + r) * 64 + lane]; st.o1[r] += as * oth[(18 + r) * 64 + lane]; } }
                attn_finish(st, lt, PB, Z, q0, hd, lane);
            }
            __syncthreads();
        }
        if (bid < 64) { unsigned* sg = ctlu + CW_SIGB + 320 + 64 * (bid >> 5); SIGNAL(sg); }
#pragma unroll 1
        for (int pi = (bid >= 64 && bid < 72) ? 0 : 1; pi < 2; ++pi) { const int unit = pi == 0 ? 192 + bid : bid;
            bf16* Ul = (bf16*)lds;
            bf16* Dl = (bf16*)(lds + 80896);
            const int r0 = unit * 64; const bool pr = r0 < SEQ; const int bb = pr ? 0 : (r0 - SEQ) >> 6;
            {
#pragma unroll
                for (int qb = 0; qb < 2; ++qb) { u32x4 sv[4];
#pragma unroll
                    for (int q = 0; q < 4; ++q) { const int i = tid + 512 * (4 * qb + q), rr = i >> 6, ch = i & 63; sv[q] = *(const u32x4*)(PB + (size_t)(r0 + rr) * 3072 + PB_U + 8 * ch); }
#pragma unroll
                    for (int q = 0; q < 4; ++q) { const int i = tid + 512 * (4 * qb + q); *(u32x4*)(Ul + (15 + (i >> 6)) * 512 + 8 * (i & 63)) = sv[q]; } }
                u32x4 hv[2] = {(u32x4){0u, 0u, 0u, 0u}, (u32x4){0u, 0u, 0u, 0u}};
#pragma unroll
                for (int q = 0; q < 2; ++q) { const int i = tid + 512 * q; if (i < 15 * 64) { const int rr = i >> 6, ch = i & 63, l = rr - 15;
                    if (pr) { if (r0 + l >= 0) hv[q] = *(const u32x4*)(PB + (size_t)(r0 + l) * 3072 + PB_U + 8 * ch); }
                    else { const float* hp = P.state_pool + (size_t)(bb * 15 + rr) * 512 + 8 * ch; const f32x4 a = *(const f32x4*)hp, b = *(const f32x4*)(hp + 4);
                        hv[q].x = pk2(a[0], a[1]); hv[q].y = pk2(a[2], a[3]); hv[q].z = pk2(b[0], b[1]); hv[q].w = pk2(b[2], b[3]); } } }
#pragma unroll
                for (int q = 0; q < 2; ++q) { const int i = tid + 512 * q; if (i < 15 * 64) *(u32x4*)(Ul + (i >> 6) * 512 + 8 * (i & 63)) = hv[q]; } }
            __syncthreads();
            {
                const int c = tid, w = 2 << (c >> 7);
                const bf16* ucol = Ul + 15 * 512 + c;
                const float invw = 1.0f / (float)w;
                float S = 0.f;
                for (int k = 1; k < w; ++k) S += bf2f(ucol[-k * 512]);
#pragma unroll 8
                for (int t = 0; t < 64; ++t) {
                    const float u = bf2f(ucol[t * 512]);
                    S += u;
                    float mean;
                    if (pr) { const int pos = r0 + t; mean = (pos + 1 < w) ? S / (float)(pos + 1) : S * invw; } else mean = S * invw;
                    Dl[t * 520 + c] = (bf16)(cvtpk(mean - u, 0.f) & 0xffffu);
                    S -= bf2f(ucol[(t - w + 1) * 512]);
                }
                if (unit == SEQ / 64 - 1) { for (int t = 0; t < 15; ++t) P.out[O_PP + (size_t)t * 512 + c] = bf2f(ucol[(49 + t) * 512]); }
                if (!pr) { for (int t = 0; t < 15; ++t) P.out[O_PS + (size_t)(bb * 15 + t) * 512 + c] = bf2f(ucol[(49 + t) * 512]); }
            }
            __syncthreads();
            {
                const int rb = wave & 1, g = wave >> 1;
                f32x16 acc[4];
#pragma unroll
                for (int nb = 0; nb < 4; ++nb) acc[nb] = f32x16{};
#pragma unroll
                for (int ks = 0; ks < 8; ++ks) { const bf16x8 a = *(const bf16x8*)(Dl + (32 * rb + r32) * 520 + g * 128 + 16 * ks + 8 * h2);
#pragma unroll
                    for (int nb = 0; nb < 4; ++nb) { const bf16x8 bw = *(const bf16x8*)(WP + ((size_t)(g * 128 + 32 * nb + r32)) * 128 + 16 * ks + 8 * h2);
                        acc[nb] = __builtin_amdgcn_mfma_f32_32x32x16_bf16(bw, a, acc[nb], 0, 0, 0); } }
                const int m = r0 + 32 * rb + r32;
#pragma unroll
                for (int nb = 0; nb < 4; ++nb) { u32x2 pgv[4]; f32x4 psv[4];
#pragma unroll
                    for (int i = 0; i < 4; ++i) { const int j = g * 128 + 32 * nb + 8 * i + 4 * h2; pgv[i] = *(const u32x2*)(PB + (size_t)m * 3072 + PB_PG + j); psv[i] = *(const f32x4*)(P.pool_scale + j); }
#pragma unroll
                    for (int i = 0; i < 4; ++i) { const int j = g * 128 + 32 * nb + 8 * i + 4 * h2; const u32x2 a = pgv[i];
                        const float a0 = __uint_as_float(a.x << 16), a1 = __uint_as_float(a.x & 0xffff0000u), a2 = __uint_as_float(a.y << 16), a3 = __uint_as_float(a.y & 0xffff0000u);
                        u32x2 w; w.x = cvtpk(acc[nb][4 * i + 0] * psv[i][0] * silu_f(a0), acc[nb][4 * i + 1] * psv[i][1] * silu_f(a1)); w.y = cvtpk(acc[nb][4 * i + 2] * psv[i][2] * silu_f(a2), acc[nb][4 * i + 3] * psv[i][3] * silu_f(a3));
                        *(u32x2*)(Z + (size_t)m * 1024 + 512 + j) = w; } }
            }
            __syncthreads();
            if (pi == 0) { unsigned* sg = ctlu + CW_SIGB + 320 + 64 * ((bid - 64) >> 2); SIGNAL(sg); }
        }
        if (bid >= 72 && bid < 80) {
            { unsigned* sg = ctlu + CW_SIGB + 320 + 64 * ((bid - 72) >> 2); WAITSIG(sg, 36u); }
            const int j = bid - 72;
            pg8::Gemm g{Z, WOUT, MT, DM, DM}; pg8::OneUnit S{64 + (j >> 2), j & 3};
            pg8::EpiMerge E{P.x_prompt, P.x_sample, P.out + O_YP, P.out + O_YS, adaG, P.final_g, rowss, pcnt};
            pg8::gemm_phase<pg8::EpiMerge, pg8::OneUnit, true, true>((LAS unsigned char*)lds, g, S, E);
        }
#undef SIGNAL
#undef WAITSIG
    }
    xcd_barrier(bar);
    TP(4);

    {
        pg8::Gemm g{Z, WOUT, MT, DM, DM}; pg8::MergeOrder S{bid, G};
        pg8::EpiMerge E{P.x_prompt, P.x_sample, P.out + O_YP, P.out + O_YS, adaG, P.final_g, rowss, pcnt};
        pg8::gemm_phase<pg8::EpiMerge, pg8::MergeOrder, true, true>((LAS unsigned char*)lds, g, S, E);
    }
    TP(5);
    if (TPROBE && bid == 0) {
        const float eps = (float)(tp1 - tp0) * 1e-5f;
        for (int i = tid; i < 4096; i += 512) P.out[O_LFS + i] *= (1.0f + eps);
    }
}

extern "C" void kernel_launch(void* const* d_in, const int* in_sizes, int n_in, void* d_out, int out_size, void* d_ws, size_t ws_size, hipStream_t stream) {
    static int grid = 0;
    if (grid == 0) {
        if (n_in != 17 || (size_t)out_size != O_END || ws_size < WS_END) { fprintf(stderr, "kernel_launch: unexpected problem shape (n_in %d, out %d, ws %zu)\n", n_in, out_size, ws_size); grid = -1; return; }
        int dev = 0, cus = 0, per_cu = 0;
        hipGetDevice(&dev); hipDeviceGetAttribute(&cus, hipDeviceAttributeMultiprocessorCount, dev);
        hipFuncSetAttribute((const void*)fox_pool_fwd, hipFuncAttributeMaxDynamicSharedMemorySize, LDS_BYTES);
        hipOccupancyMaxActiveBlocksPerMultiprocessor(&per_cu, (const void*)fox_pool_fwd, 512, LDS_BYTES);
        (void)hipGetLastError();
        if (per_cu < 1) { fprintf(stderr, "kernel_launch: occupancy query reports %d blocks per CU\n", per_cu); per_cu = 1; }
        grid = cus * 1;
        if (grid != 256) fprintf(stderr, "kernel_launch: this build's phase program is dealt for a 256-workgroup grid (256 CUs); found %d CUs\n", cus);
    }
    if (grid < 0) return;
    hipMemsetAsync((char*)d_ws + WS_CTL, 0, CTL_BYTES, stream);
    Params p{};
    const float** pp = (const float**)&p;
    for (int i = 0; i < 17; ++i) pp[i] = (const float*)d_in[i];
    p.out = (float*)d_out; p.ws = (unsigned char*)d_ws;
    void* args[] = {&p};
    hipError_t e = hipLaunchCooperativeKernel((const void*)fox_pool_fwd, dim3(grid), dim3(512), args, LDS_BYTES, stream);
    if (e != hipSuccess) fprintf(stderr, "cooperative launch failed: %s (grid %d)\n", hipGetErrorString(e), grid);
}
```
